# Optimizing an MI355X kernel written in HIP

```python
import jax, jax.numpy as jnp
from jax import lax
import numpy as np

D_MODEL = 1024
BATCH = 16
SEQ = 2048
DEPTH = 1

N_META = 16
D_MIX = D_MODEL
MLA_HEADS = 4
QK_NOPE_DIM = 128
QK_ROPE_DIM = 64
V_HEAD_DIM = 128
MLA_WIDTH = MLA_HEADS * V_HEAD_DIM
Q_LORA_RANK = 256
KV_LORA_RANK = 128
ROPE_THETA = 10000.0
ATTN_SCALE = (QK_NOPE_DIM + QK_ROPE_DIM) ** -0.5
Q_BLOCK = 128
NEG_INF = -1e30
CONV_WIDTH = D_MIX - MLA_WIDTH
CONV_GROUPS = 8
CONV_KSIZE = 3
IN_SPLITS = (Q_LORA_RANK, KV_LORA_RANK, QK_ROPE_DIM, MLA_WIDTH,
             CONV_WIDTH, CONV_WIDTH, CONV_WIDTH, CONV_WIDTH)
IN_PROJ_DIM = sum(IN_SPLITS)
EPS = 1e-6

kernel_name = "hymba_mla_shortconv_hybrid"


def rms_norm(x, g):
    xf = x.astype(jnp.float32)
    y = xf * lax.rsqrt(jnp.mean(xf * xf, axis=-1, keepdims=True) + EPS)
    return (y * g.astype(jnp.float32)).astype(x.dtype)


def apply_rope(x, pos):
    half = x.shape[-1] // 2
    inv_freq = 1.0 / (ROPE_THETA ** (jnp.arange(half, dtype=jnp.float32) / half))
    ang = pos.astype(jnp.float32)[:, None] * inv_freq[None, :]
    cos = jnp.cos(ang)[None, :, None, :]
    sin = jnp.sin(ang)[None, :, None, :]
    xf = x.astype(jnp.float32)
    x1, x2 = xf[..., :half], xf[..., half:]
    return jnp.concatenate([x1 * cos - x2 * sin, x2 * cos + x1 * sin], axis=-1).astype(x.dtype)


def _attend_block(q_blk, q_pos, k, v, k_pos):
    s = jnp.einsum('bqhd,bkhd->bhqk', q_blk, k, preferred_element_type=jnp.float32) * ATTN_SCALE
    mask = k_pos[None, :] <= q_pos[:, None]
    s = jnp.where(mask[None, None], s, NEG_INF)
    p = jax.nn.softmax(s, axis=-1)
    return jnp.einsum('bhqk,bkhd->bqhd', p.astype(v.dtype), v)


def causal_attention(q, k, v):
    B, T, H, _ = q.shape
    pos = jnp.arange(T)
    o_meta = _attend_block(q[:, :N_META], pos[:N_META], k[:, :N_META], v[:, :N_META], pos[:N_META])
    n_blk = (T - N_META) // Q_BLOCK
    q_real = q[:, N_META:].reshape(B, n_blk, Q_BLOCK, H, q.shape[-1]).transpose(1, 0, 2, 3, 4)
    q_pos = pos[N_META:].reshape(n_blk, Q_BLOCK)
    o_real = lax.map(lambda a: _attend_block(a[0], a[1], k, v, pos), (q_real, q_pos))
    o_real = o_real.transpose(1, 0, 2, 3, 4).reshape(B, T - N_META, H, v.shape[-1])
    return jnp.concatenate([o_meta, o_real], axis=1)


def causal_dwconv(u, w):
    C = u.shape[-1]
    return lax.conv_general_dilated(
        u, w[:, None, :].astype(u.dtype), window_strides=(1,), padding=[(CONV_KSIZE - 1, 0)],
        dimension_numbers=('NWC', 'WIO', 'NWC'), feature_group_count=C)


def hybrid_layer(h, norm_g, w_in, q_norm_g, w_q_up, kv_norm_g, w_kv_up, conv_w,
                 attn_out_g, conv_out_g, w_out):
    B, T, _ = h.shape
    pos = jnp.arange(T)
    u = rms_norm(h, norm_g)
    p = u @ w_in
    idx = np.cumsum(IN_SPLITS)[:-1].tolist()
    c_q, c_kv, k_rope, z_attn, conv_b, conv_c, conv_h, z_conv = jnp.split(p, idx, axis=-1)

    q = (rms_norm(c_q, q_norm_g) @ w_q_up).reshape(B, T, MLA_HEADS, QK_NOPE_DIM + QK_ROPE_DIM)
    q_nope, q_pe = q[..., :QK_NOPE_DIM], q[..., QK_NOPE_DIM:]
    q_pe = apply_rope(q_pe, pos)
    kv = (rms_norm(c_kv, kv_norm_g) @ w_kv_up).reshape(B, T, MLA_HEADS, QK_NOPE_DIM + V_HEAD_DIM)
    k_nope, v = kv[..., :QK_NOPE_DIM], kv[..., QK_NOPE_DIM:]
    k_pe = apply_rope(k_rope[:, :, None, :], pos)
    k_pe = jnp.broadcast_to(k_pe, (B, T, MLA_HEADS, QK_ROPE_DIM))
    q_full = jnp.concatenate([q_nope, q_pe], axis=-1)
    k_full = jnp.concatenate([k_nope, k_pe], axis=-1)
    o = causal_attention(q_full, k_full, v)
    o = rms_norm(o, attn_out_g.reshape(MLA_HEADS, V_HEAD_DIM)).reshape(B, T, MLA_WIDTH)
    y_attn = o * jax.nn.silu(z_attn)

    yc = conv_b * causal_dwconv(conv_c * conv_h, conv_w)
    yc = rms_norm(yc.reshape(B, T, CONV_GROUPS, CONV_WIDTH // CONV_GROUPS),
                  conv_out_g.reshape(CONV_GROUPS, CONV_WIDTH // CONV_GROUPS)).reshape(B, T, CONV_WIDTH)
    y_conv = yc * jax.nn.silu(z_conv)

    mix = jnp.concatenate([y_attn, y_conv], axis=-1) @ w_out
    return h + mix


def setup_inputs(seed: int = 0) -> dict:
    key = jax.random.key(seed)
    ks = jax.random.split(key, 16)
    f32 = jnp.float32

    def w(k, shape, fan_in):
        return jax.random.normal(k, shape, f32) * fan_in ** -0.5

    def gain(k, shape):
        return 1.0 + 0.02 * jax.random.normal(k, shape, f32)

    return {
        "x": jax.random.normal(ks[0], (BATCH, SEQ, D_MODEL), f32),
        "meta_tokens": jax.random.normal(ks[1], (N_META, D_MODEL), f32),
        "norm_g": gain(ks[2], (DEPTH, D_MODEL)),
        "w_in": w(ks[3], (DEPTH, D_MODEL, IN_PROJ_DIM), D_MODEL),
        "q_norm_g": gain(ks[4], (DEPTH, Q_LORA_RANK)),
        "w_q_up": w(ks[5], (DEPTH, Q_LORA_RANK, MLA_HEADS * (QK_NOPE_DIM + QK_ROPE_DIM)), Q_LORA_RANK),
        "kv_norm_g": gain(ks[6], (DEPTH, KV_LORA_RANK)),
        "w_kv_up": w(ks[7], (DEPTH, KV_LORA_RANK, MLA_HEADS * (QK_NOPE_DIM + V_HEAD_DIM)), KV_LORA_RANK),
        "conv_w": w(ks[8], (DEPTH, CONV_KSIZE, CONV_WIDTH), CONV_KSIZE),
        "attn_out_g": gain(ks[9], (DEPTH, MLA_WIDTH)),
        "conv_out_g": gain(ks[10], (DEPTH, CONV_WIDTH)),
        "w_out": w(ks[11], (DEPTH, D_MIX, D_MODEL), D_MIX),
        "final_norm_g": gain(ks[12], (D_MODEL,)),
    }


def reference(x, meta_tokens, norm_g, w_in, q_norm_g, w_q_up, kv_norm_g, w_kv_up, conv_w,
              attn_out_g, conv_out_g, w_out, final_norm_g):
    B = x.shape[0]
    meta = jnp.broadcast_to(meta_tokens[None].astype(x.dtype), (B, N_META, x.shape[-1]))
    h = jnp.concatenate([meta, x], axis=1)
    for l in range(DEPTH):
        h = hybrid_layer(h, norm_g[l], w_in[l], q_norm_g[l], w_q_up[l], kv_norm_g[l], w_kv_up[l],
                         conv_w[l], attn_out_g[l], conv_out_g[l], w_out[l])
    return rms_norm(h, final_norm_g)[:, N_META:]
```

```cpp
#include <hip/hip_runtime.h>
#include <hip/hip_cooperative_groups.h>
#include <cstdio>
#include <cmath>
namespace cg = cooperative_groups;

#define LAS __attribute__((address_space(3)))
#define DI __device__ __forceinline__
typedef unsigned short bf16_t;
typedef short bf16x8 __attribute__((ext_vector_type(8)));
typedef short s16x4 __attribute__((ext_vector_type(4)));
typedef float f32x4 __attribute__((ext_vector_type(4)));
typedef float f32x2 __attribute__((ext_vector_type(2)));
typedef float f32x16 __attribute__((ext_vector_type(16)));
typedef unsigned u32x4 __attribute__((ext_vector_type(4)));
typedef unsigned u32x2 __attribute__((ext_vector_type(2)));

#define REP0 1
#define REP1 1
#define REP2 1
#define REP3 1
#define REP4 1
#define REP5 1
#define REPSYNC 0
constexpr int NTOK = 32768;
constexpr int SEQ = 2048;
constexpr int DM = 1024;
constexpr int NMETA = 16;
constexpr int NIN = 3008;
constexpr int N1 = 3072;
constexpr int N2 = 768;
constexpr int K2 = 256;
constexpr float EPS = 1e-6f;
constexpr float QSCALE = 0.07216878364870322f * 1.4426950408889634f;
constexpr int C_CKV = 256, C_KR = 384, C_ZA = 448, C_PAD = 960, C_CONV = 1024;

constexpr size_t WS_XB = 0;
constexpr size_t WS_MIX = WS_XB + (size_t)NTOK * DM * 2;
constexpr size_t WS_P = WS_MIX + (size_t)NTOK * DM * 2;
constexpr size_t WS_Q = WS_P + (size_t)NTOK * N1 * 2;
constexpr size_t WS_NKV = WS_Q + (size_t)NTOK * 768 * 2;
constexpr size_t WS_KPE = WS_NKV + (size_t)NTOK * 128 * 2;
constexpr size_t WS_W1T = WS_KPE + (size_t)NTOK * 64 * 2;
constexpr size_t WS_W2T = WS_W1T + (size_t)N1 * DM * 2;
constexpr size_t WS_W3T = WS_W2T + (size_t)N2 * K2 * 2;
constexpr size_t WS_PMETA = WS_W3T + (size_t)DM * DM * 2;
constexpr size_t WS_NKVM = WS_PMETA + (size_t)16 * N1 * 2;
constexpr size_t WS_KPEMETA = WS_NKVM + (size_t)16 * 128 * 2;
constexpr size_t WS_CS = WS_KPEMETA + (size_t)16 * 64 * 2;
constexpr size_t WS_RSTDH = WS_CS + (size_t)2064 * 32 * 8;
constexpr size_t WS_SSQQ = WS_RSTDH + (size_t)NTOK * 4;
constexpr size_t WS_SSQKV = WS_SSQQ + (size_t)NTOK * 4;
constexpr size_t WS_SSQO = WS_SSQKV + (size_t)NTOK * 4;
constexpr size_t WS_WVT = WS_SSQO + (size_t)NTOK * 4;
constexpr size_t WS_MG = WS_WVT + (size_t)512 * 128 * 2;
constexpr size_t WS_RSTDM = WS_MG + (size_t)16 * DM * 2;
constexpr size_t WS_BAR = WS_RSTDM + 256;
constexpr size_t WS_END = WS_BAR + 65536;

struct Params {
    const float* x; const float* meta; const float* norm_g; const float* w_in; const float* q_norm_g; const float* w_q_up;
    const float* kv_norm_g; const float* w_kv_up; const float* conv_w; const float* attn_out_g; const float* conv_out_g;
    const float* w_out; const float* final_g;
    float* out; unsigned char* ws;
    float inv_freq[32];
    int ph_lo, ph_hi;
};

DI unsigned cvt_pk_bf16(float lo, float hi) { unsigned r; asm volatile("v_cvt_pk_bf16_f32 %0, %1, %2" : "=v"(r) : "v"(lo), "v"(hi)); return r; }
DI float bf_lo(unsigned u) { return __uint_as_float(u << 16); }
DI float bf_hi(unsigned u) { return __uint_as_float(u & 0xffff0000u); }
DI float bf2f(bf16_t b) { return __uint_as_float(((unsigned)b) << 16); }
DI bf16_t f2bf(float f) { unsigned u = __float_as_uint(f); u += 0x7FFFu + ((u >> 16) & 1u); return (bf16_t)(u >> 16); }
DI float silu(float z) { return z * __builtin_amdgcn_rcpf(1.0f + __builtin_amdgcn_exp2f(-1.4426950408889634f * z)); }
DI float max_x32(float x) { const u32x2 r = __builtin_amdgcn_permlane32_swap(__float_as_uint(x), __float_as_uint(x), false, false); return fmaxf(__uint_as_float(r.x), __uint_as_float(r.y)); }
DI float sum_x32(float x) { const u32x2 r = __builtin_amdgcn_permlane32_swap(__float_as_uint(x), __float_as_uint(x), false, false); return __uint_as_float(r.x) + __uint_as_float(r.y); }
DI void swap_x32(u32x2& a, u32x2& b) {
    const u32x2 rx = __builtin_amdgcn_permlane32_swap(a.x, b.x, false, false), ry = __builtin_amdgcn_permlane32_swap(a.y, b.y, false, false);
    a.x = rx.x; b.x = rx.y; a.y = ry.x; b.y = ry.y;
}
DI float wave_sum(float v) {
#pragma unroll
    for (int o = 32; o >= 1; o >>= 1) v += __shfl_xor(v, o);
    return v;
}
DI int colmap1(int n) {
    if (n < C_KR) return n;
    if (n < C_ZA) { const int j = n - C_KR; return C_KR + (j >> 1) + 32 * (j & 1); }
    if (n < C_PAD) return n;
    if (n < C_CONV) return -1;
    const int u = n - C_CONV, g = u >> 8, cl = u & 255;
    const int t = ((cl >> 7) << 1) | ((cl >> 2) & 1), ch = ((cl >> 5) & 3) * 16 + ((cl >> 3) & 3) * 4 + (cl & 3);
    return 960 + 512 * t + 64 * g + ch;
}
DI int colmap2q(int n) {
    const int h = n / 192, d = n - h * 192;
    if (d < 128) return n;
    const int j = d - 128; return h * 192 + 128 + (j >> 1) + 32 * (j & 1);
}


#define XB_TMO      128
#define XB_XCNT(j)  (256  + 64 * (j))
#define XB_XSUB(j)  (1280 + 64 * (j))
#define XB_XGEN(j)  (2304 + 64 * (j))
#define XB_TOP      3328
#define XB_TOPGEN   3392
#define XCD_BAR_WORDS 3456
#define XB_SPIN_CAP (1u << 18)
DI unsigned xb_ld(unsigned* p)              { return __hip_atomic_load(p, __ATOMIC_RELAXED, __HIP_MEMORY_SCOPE_AGENT); }
DI unsigned xb_add(unsigned* p, unsigned v) { return __hip_atomic_fetch_add(p, v, __ATOMIC_RELAXED, __HIP_MEMORY_SCOPE_AGENT); }
DI unsigned xb_xcc_id() { return (unsigned)__builtin_amdgcn_s_getreg((3 << 11) | 20) & 0xFu; }
#define XB_SPIN(cond, bar) do { unsigned _sp = 0; while (cond) { __builtin_amdgcn_s_sleep(1); \
    if ((++_sp & 255u) == 0u) { if (xb_ld(&(bar)[XB_TMO])) break; if (_sp > XB_SPIN_CAP) { atomicAdd(&(bar)[XB_TMO], 1u); break; } } } } while (0)
struct XcdBarrier { unsigned* bar; unsigned x; volatile LAS unsigned* st; };
DI XcdBarrier xcd_barrier_post(unsigned* bar, volatile LAS unsigned* st) {
    XcdBarrier b; b.bar = bar; b.x = xb_xcc_id(); b.st = st;
    if (threadIdx.x == 0) (void)xb_add(&bar[XB_XCNT(b.x)], 1u);
    return b;
}
DI void xcd_barrier_complete(unsigned* bar, unsigned x, unsigned& nloc, unsigned& nx) {
    const unsigned G = gridDim.x * gridDim.y * gridDim.z;
    unsigned sum, cnt, mine, sp = 0u;
    for (;;) {
        sum = 0u; cnt = 0u; mine = 0u;
#pragma unroll
        for (unsigned j = 0; j < 16; ++j) { const unsigned c = xb_ld(&bar[XB_XCNT(j)]); sum += c; cnt += (c > 0u) ? 1u : 0u; mine = (j == x) ? c : mine; }
        if (sum == G) break;
        __builtin_amdgcn_s_sleep(1);
        if ((++sp & 255u) == 0u) { if (xb_ld(&bar[XB_TMO])) break; if (sp > XB_SPIN_CAP) { atomicAdd(&bar[XB_TMO], 1u); break; } }
    }
    nloc = mine > 0u ? mine : 1u; nx = cnt > 0u ? cnt : 1u;
}
DI void xcd_barrier(const XcdBarrier& b) {
    asm volatile("s_waitcnt vmcnt(0)" ::: "memory");
    __syncthreads();
    if (threadIdx.x == 0) {
        unsigned* bar = b.bar;
        __builtin_amdgcn_s_waitcnt(0);
        unsigned nloc = b.st[0], nx = b.st[1];
        if (nloc == 0u) { xcd_barrier_complete(bar, b.x, nloc, nx); b.st[0] = nloc; b.st[1] = nx; }
        const unsigned old = xb_add(&bar[XB_XSUB(b.x)], 1u);
        const unsigned gen = old / nloc;
        if (old + 1u == (gen + 1u) * nloc) {
            __builtin_amdgcn_fence(__ATOMIC_RELEASE, "agent");
            asm volatile("s_waitcnt vmcnt(0)" ::: "memory");
            const unsigned og = xb_add(&bar[XB_TOP], 1u);
            const unsigned tg = og / nx;
            if (og + 1u == (tg + 1u) * nx) xb_add(&bar[XB_TOPGEN], 1u);
            else XB_SPIN(xb_ld(&bar[XB_TOPGEN]) == tg, bar);
            __builtin_amdgcn_fence(__ATOMIC_ACQUIRE, "agent");
            xb_add(&bar[XB_XGEN(b.x)], 1u);
            asm volatile("s_waitcnt vmcnt(0)" ::: "memory");
        } else {
            XB_SPIN(xb_ld(&bar[XB_XGEN(b.x)]) == gen, bar);
            __builtin_amdgcn_fence(__ATOMIC_ACQUIRE, "agent");
            asm volatile("s_waitcnt vmcnt(0)" ::: "memory");
        }
    }
    __syncthreads();
}

namespace pg8 {
constexpr int BM = 256, BK = 64, HALF = 128, HTB = HALF * BK * 2, STAGE_BYTES = 8 * HTB, NXCD = 8, WGM = 8;
DI int lds_byte(int r, int c) { const int st = (r >> 4) * 2 + (c >> 5), rr = r & 15, cc = c & 31, ob = rr * 64 + cc * 2; return st * 1024 + (ob ^ (((ob >> 9) & 1) << 5)); }
DI void stage_rc(int b, int& R, int& C) { const int st = b / 1024, sb = b % 1024, swz = sb ^ (((sb >> 9) & 1) << 5); R = (st >> 1) * 16 + swz / 64; C = (st & 1) * 32 + (swz % 64) / 2; }
DI int perm32(int rho) { const int n = rho >> 4, i = rho & 15; return 8 * (i >> 2) + 4 * n + (i & 3); }
struct Unit { int pm, pn; };
struct Gemm { const bf16_t* A; const bf16_t* Bt; int lda, ldb, K, nM, nN; int aoff_pn, aoff_bytes; };
struct StaticOrder {
    int nM, nN, nwg, G, c;
    DI void init(int nM_, int nN_, int G_, int c_) { nM = nM_; nN = nN_; nwg = nM * nN; G = G_; c = c_; }
    DI bool next(int i, Unit& u) const {
        const long L = (long)i * G + c; if (L >= nwg) return false;
        int wgid = (int)L; { const int q = nwg / NXCD, r = nwg % NXCD, xcd = wgid % NXCD, off = wgid / NXCD; wgid = (xcd < r ? xcd * (q + 1) : r * (q + 1) + (xcd - r) * q) + off; }
        const int nig = WGM * nN, gid = wgid / nig, fm = gid * WGM, gsz = (nM - fm) < WGM ? (nM - fm) : WGM;
        u.pm = fm + ((wgid % nig) % gsz); u.pn = (wgid % nig) / gsz; return true;
    }
};

template <class Epi>
DI void gemm_phase(LAS unsigned char* lds, const Gemm g, const StaticOrder& S, const Epi& E) {
    const int tid = threadIdx.x, wid = __builtin_amdgcn_readfirstlane(tid >> 6), lane = tid & 63, wr = wid >> 2, wc = wid & 3, fr = lane & 15, fq = lane >> 4;
    int K = g.K; asm volatile("" : "+s"(K)); const int nt = K / BK;
    unsigned voffA[2], voffB[2];
#pragma unroll
    for (int i = 0; i < 2; ++i) { int R, C; stage_rc(tid * 16 + i * 8192, R, C); const int Rb = Epi::PERM ? ((R & ~31) + perm32(R & 31)) : R;
        voffA[i] = (unsigned)(R * g.lda + C) * 2u; voffB[i] = (unsigned)(Rb * g.ldb + C) * 2u; }
    const size_t kstep = (size_t)(BK * 2);
    const size_t hstepA = (size_t)HALF * g.lda * 2, hstepB = (size_t)HALF * g.ldb * 2;
    const size_t tstepA = 2 * hstepA, tstepB = 2 * hstepB;
    const unsigned ldsw = (unsigned)wid * 1024u;
    const int aoff = lds_byte(wr * 64 + fr, fq * 8), boff = lds_byte(wc * 32 + fr, fq * 8);
#define PG8_SA(b, h) (((b) * 2 + (h)) * HTB)
#define PG8_SB(b, h) ((4 + (b) * 2 + (h)) * HTB)
#define PG8_STAGE(bufoff, gbase, voff) do { _Pragma("unroll") for (int _i = 0; _i < 2; ++_i) \
        __builtin_amdgcn_global_load_lds((const unsigned*)((const char*)(gbase) + (voff)[_i]), (LAS unsigned*)(lds + (bufoff) + ldsw + _i * 8192), 16, 0, 0); } while (0)
#define PG8_LDA(dst, b, h) do { _Pragma("unroll") for (int m = 0; m < 4; ++m) _Pragma("unroll") for (int k = 0; k < 2; ++k) dst[m][k] = *(const LAS bf16x8*)(lds + PG8_SA(b, h) + aoff + m * 2048 + k * 1024); } while (0)
#define PG8_LDB(dst, b, h) do { _Pragma("unroll") for (int n = 0; n < 2; ++n) _Pragma("unroll") for (int k = 0; k < 2; ++k) dst[n][k] = *(const LAS bf16x8*)(lds + PG8_SB(b, h) + boff + n * 2048 + k * 1024); } while (0)
#define PG8_MMA(ai, bj, At, Bt) do { __builtin_amdgcn_s_setprio(1); _Pragma("unroll") for (int m = 0; m < 4; ++m) _Pragma("unroll") for (int n = 0; n < 2; ++n) _Pragma("unroll") for (int k = 0; k < 2; ++k) \
        acc[ai][bj][m][n] = __builtin_amdgcn_mfma_f32_16x16x32_bf16(Bt[n][k], At[m][k], acc[ai][bj][m][n], 0, 0, 0); __builtin_amdgcn_s_setprio(0); } while (0)
#define PG8_WAIT_V(n) asm volatile("s_waitcnt vmcnt(" #n ")" ::: "memory")
#define PG8_WAIT_L(n) asm volatile("s_waitcnt lgkmcnt(" #n ")" ::: "memory")
#define PG8_BAR __builtin_amdgcn_s_barrier()
#define PG8_SCHED __builtin_amdgcn_sched_barrier(0)
    Unit cur, nxt; int ui = 0;
    if (!S.next(0, cur)) return;
    f32x4 acc[2][2][4][2];
#pragma unroll
    for (int a = 0; a < 2; ++a)
#pragma unroll
        for (int b = 0; b < 2; ++b)
#pragma unroll
            for (int m = 0; m < 4; ++m)
#pragma unroll
                for (int n = 0; n < 2; ++n) acc[a][b][m][n] = (f32x4){0.f, 0.f, 0.f, 0.f};
    bf16x8 At[4][2], B0[2][2], B1[2][2];
    const char* cA = (const char*)g.A + (size_t)cur.pm * tstepA + (cur.pn >= g.aoff_pn ? g.aoff_bytes : 0);
    const char* cB = (const char*)g.Bt + (size_t)cur.pn * tstepB;
    PG8_STAGE(PG8_SB(0, 0), cB, voffB); PG8_STAGE(PG8_SA(0, 0), cA, voffA); PG8_STAGE(PG8_SB(0, 1), cB + hstepB, voffB); PG8_STAGE(PG8_SA(0, 1), cA + hstepA, voffA);
    if (wr == 1) PG8_BAR;
    PG8_WAIT_V(4); PG8_BAR;
    PG8_STAGE(PG8_SB(1, 0), cB + kstep, voffB); PG8_STAGE(PG8_SA(1, 0), cA + kstep, voffA); PG8_STAGE(PG8_SB(1, 1), cB + hstepB + kstep, voffB);
    PG8_WAIT_V(6); PG8_BAR;
    for (;;) {
        const bool has_next = S.next(ui + 1, nxt);
        const char* nA = has_next ? (const char*)g.A + (size_t)nxt.pm * tstepA + (nxt.pn >= g.aoff_pn ? g.aoff_bytes : 0) : cA;
        const char* nB = has_next ? (const char*)g.Bt + (size_t)nxt.pn * tstepB : cB;
        for (int t = 0; t < nt; t += 2) {
            const bool last = (t == nt - 2);
            const char* a1 = cA + (size_t)(t + 1) * kstep; const char* b1u = cB; (void)b1u;
            const char* a2 = last ? nA : cA + (size_t)(t + 2) * kstep; const char* b2 = last ? nB : cB + (size_t)(t + 2) * kstep;
            const char* a3 = a2 + kstep; const char* b3 = b2 + kstep;
            PG8_LDB(B0, 0, 0); PG8_SCHED; PG8_LDA(At, 0, 0); PG8_STAGE(PG8_SA(1, 1), a1 + hstepA, voffA);
            PG8_WAIT_L(8); PG8_BAR; PG8_WAIT_L(0); PG8_MMA(0, 0, At, B0); PG8_BAR; PG8_SCHED;
            PG8_LDB(B1, 0, 1); PG8_STAGE(PG8_SB(0, 0), b2, voffB);
            PG8_BAR; PG8_WAIT_L(0); PG8_MMA(0, 1, At, B1); PG8_BAR;
            PG8_LDA(At, 0, 1); PG8_STAGE(PG8_SA(0, 0), a2, voffA);
            PG8_BAR; PG8_WAIT_L(0); PG8_MMA(1, 0, At, B0); PG8_BAR; PG8_SCHED;
            PG8_STAGE(PG8_SB(0, 1), b2 + hstepB, voffB);
            PG8_WAIT_V(6); PG8_BAR; PG8_MMA(1, 1, At, B1); PG8_BAR;
            PG8_LDB(B0, 1, 0); PG8_SCHED; PG8_LDA(At, 1, 0); PG8_STAGE(PG8_SA(0, 1), a2 + hstepA, voffA);
            PG8_WAIT_L(8); PG8_BAR; PG8_WAIT_L(0); PG8_MMA(0, 0, At, B0); PG8_BAR; PG8_SCHED;
            PG8_LDB(B1, 1, 1); PG8_STAGE(PG8_SB(1, 0), b3, voffB);
            PG8_BAR; PG8_WAIT_L(0); PG8_MMA(0, 1, At, B1); PG8_BAR;
            PG8_LDA(At, 1, 1); PG8_STAGE(PG8_SA(1, 0), a3, voffA);
            PG8_BAR; PG8_WAIT_L(0); PG8_MMA(1, 0, At, B0); PG8_BAR; PG8_SCHED;
            PG8_STAGE(PG8_SB(1, 1), b3 + hstepB, voffB);
            PG8_WAIT_V(6); PG8_BAR; PG8_MMA(1, 1, At, B1); PG8_BAR;
        }
        E(acc, cur, wr, wc, fr, fq);
        if (!has_next) break;
#pragma unroll
        for (int a = 0; a < 2; ++a)
#pragma unroll
            for (int b = 0; b < 2; ++b)
#pragma unroll
                for (int m = 0; m < 4; ++m)
#pragma unroll
                    for (int n = 0; n < 2; ++n) acc[a][b][m][n] = (f32x4){0.f, 0.f, 0.f, 0.f};
        cur = nxt; cA = nA; cB = nB; ++ui;
    }
    PG8_WAIT_V(0);
    if (wr == 0) PG8_BAR;
    PG8_BAR;
#undef PG8_SA
#undef PG8_SB
#undef PG8_STAGE
#undef PG8_LDA
#undef PG8_LDB
#undef PG8_MMA
#undef PG8_WAIT_V
#undef PG8_WAIT_L
#undef PG8_BAR
#undef PG8_SCHED
}
}

DI float dpp_ror1(float x) { return __builtin_bit_cast(float, __builtin_amdgcn_update_dpp(0, __builtin_bit_cast(int, x), 0x121, 0xf, 0xf, false)); }
DI float dpp_ror2(float x) { return __builtin_bit_cast(float, __builtin_amdgcn_update_dpp(0, __builtin_bit_cast(int, x), 0x122, 0xf, 0xf, false)); }
DI void rope8_load(f32x4& t0, f32x4& t1, const float* cs  , int pos, int i0) {
    t0 = *(const f32x4*)(cs + ((size_t)pos * 32 + i0) * 2);
    t1 = *(const f32x4*)(cs + ((size_t)pos * 32 + i0 + 2) * 2);
}
DI void rope8_apply(f32x4& v0, f32x4& v1, const f32x4& t0, const f32x4& t1) {
    f32x4 o0, o1;
    o0[0] = v0[0] * t0[0] - v0[1] * t0[1]; o0[1] = v0[1] * t0[0] + v0[0] * t0[1];
    o0[2] = v0[2] * t0[2] - v0[3] * t0[3]; o0[3] = v0[3] * t0[2] + v0[2] * t0[3];
    o1[0] = v1[0] * t1[0] - v1[1] * t1[1]; o1[1] = v1[1] * t1[0] + v1[0] * t1[1];
    o1[2] = v1[2] * t1[2] - v1[3] * t1[3]; o1[3] = v1[3] * t1[2] + v1[2] * t1[3];
    v0 = o0; v1 = o1;
}
DI u32x4 pack8(const f32x4& v0, const f32x4& v1) {
    u32x4 w; w.x = cvt_pk_bf16(v0[0], v0[1]); w.y = cvt_pk_bf16(v0[2], v0[3]); w.z = cvt_pk_bf16(v1[0], v1[1]); w.w = cvt_pk_bf16(v1[2], v1[3]); return w;
}
DI float sq8(const f32x4& v0, const f32x4& v1) {
    return (v0[0] * v0[0] + v0[1] * v0[1]) + (v0[2] * v0[2] + v0[3] * v0[3]) + (v1[0] * v1[0] + v1[1] * v1[1]) + (v1[2] * v1[2] + v1[3] * v1[3]);
}

struct Epi1 {
    static constexpr bool PERM = true;
    DI void conv_epi(const f32x4 (&acc)[2][2][4][2], const pg8::Unit& u, int wr, int wc, int fr, int fq, const float (&rsv)[2][4]) const {
        const int row0 = u.pm * 256 + wr * 64 + fr, col0 = u.pn * 256 + wc * 32 + 8 * fq;
        const int chb = (u.pn - 4) * 64 + 16 * wc + 4 * fq;
        const f32x4 w0 = *(const f32x4*)(conv_w + chb), w1 = *(const f32x4*)(conv_w + 512 + chb), w2 = *(const f32x4*)(conv_w + 1024 + chb);
        f32x4 yc[8], p1 = (f32x4){0.f, 0.f, 0.f, 0.f}, p2 = p1;
#pragma unroll
        for (int it = 0; it < 8; ++it) {
            const int ai = it >> 2, m = it & 3, row = row0 + ai * 128 + m * 16;
            const float rs = rsv[ai][m];
            const f32x4 b = acc[ai][0][m][0] * rs, c = acc[ai][0][m][1] * rs, h = acc[ai][1][m][0] * rs;
            const f32x4 ch0 = c * h;
            f32x4 y1, y2;
#pragma unroll
            for (int j = 0; j < 4; ++j) { y1[j] = dpp_ror1(ch0[j]); y2[j] = dpp_ror2(ch0[j]); }
            const f32x4 v1 = (fr >= 1) ? y1 : p1, v2 = (fr >= 2) ? y2 : p2;
            p1 = y1; p2 = y2;
            const f32x4 y = b * (w0 * v2 + w1 * v1 + w2 * ch0);
            yc[it] = y;
            float ss = (y[0] * y[0] + y[1] * y[1]) + (y[2] * y[2] + y[3] * y[3]);
            ss += __shfl_xor(ss, 16); ss += __shfl_xor(ss, 32);
            if (fq == 0) part[((wr * 8 + it) * 16 + fr) * 4 + wc] = ss;
            if ((m == 0 && fr < 2) || (m == 3 && fr >= 14)) {
                const f32x4 z = acc[ai][1][m][1] * rs;
                *(u32x4*)(P + (size_t)row * N1 + col0) = pack8(b, c);
                *(u32x4*)(P + (size_t)row * N1 + col0 + 128) = pack8(h, z);
            }
        }
        asm volatile("s_waitcnt lgkmcnt(0)" ::: "memory"); __builtin_amdgcn_s_barrier(); asm volatile("" ::: "memory");
#pragma unroll
        for (int it = 0; it < 8; ++it) {
            const int ai = it >> 2, m = it & 3, row = row0 + ai * 128 + m * 16;
            const f32x4 pp = *(const LAS f32x4*)(part + ((wr * 8 + it) * 16 + fr) * 4);
            const float rsg = rsqrtf(((pp[0] + pp[1]) + (pp[2] + pp[3])) * (1.0f / 64.0f) + EPS);
            const f32x4 z = acc[ai][1][m][1] * rsv[ai][m];
            u32x2 w;
            w.x = cvt_pk_bf16(yc[it][0] * rsg * silu(z[0]), yc[it][1] * rsg * silu(z[1])); w.y = cvt_pk_bf16(yc[it][2] * rsg * silu(z[2]), yc[it][3] * rsg * silu(z[3]));
            if (!(m == 0 && fr < 2)) *(u32x2*)(MIX + (size_t)row * DM + 512 + chb) = w;
        }
    }
    bf16_t* P; bf16_t* KPE; const float* rstd; float* ssq_q; float* ssq_kv; const float* cs; bool acc_on;
    bf16_t* MIX; const float* conv_w; LAS float* part;
    DI void operator()(const f32x4 (&acc)[2][2][4][2], const pg8::Unit& u, int wr, int wc, int fr, int fq) const {
        const int row0 = u.pm * 256 + wr * 64 + fr, col0 = u.pn * 256 + wc * 32 + 8 * fq;
        float rsv[2][4];
#pragma unroll
        for (int ai = 0; ai < 2; ++ai)
#pragma unroll
            for (int m = 0; m < 4; ++m) rsv[ai][m] = rstd[row0 + ai * 128 + m * 16];
        if (u.pn >= 4) { conv_epi(acc, u, wr, wc, fr, fq, rsv); return; }
        const bool do_rope = (u.pn == 1) && (wc < 2);
        f32x4 tn0 = (f32x4){0.f, 0.f, 0.f, 0.f}, tn1 = tn0;
        if (do_rope) rope8_load(tn0, tn1, cs, (row0 & (SEQ - 1)) + NMETA, 16 * wc + 4 * fq);
#pragma unroll
        for (int ai = 0; ai < 2; ++ai)
#pragma unroll
            for (int m = 0; m < 4; ++m) {
                const int row = row0 + ai * 128 + m * 16;
                const float rs = rsv[ai][m];
                const f32x4 tc0 = tn0, tc1 = tn1;
                if (do_rope && (ai * 4 + m) < 7) { const int rown = row0 + ((ai * 4 + m + 1) >> 2) * 128 + ((ai * 4 + m + 1) & 3) * 16; rope8_load(tn0, tn1, cs, (rown & (SEQ - 1)) + NMETA, 16 * wc + 4 * fq); }
                float sq[2];
#pragma unroll
                for (int bj = 0; bj < 2; ++bj) {
                    f32x4 v0 = acc[ai][bj][m][0] * rs, v1 = acc[ai][bj][m][1] * rs;
                    sq[bj] = sq8(v0, v1);
                    *(u32x4*)(P + (size_t)row * N1 + col0 + bj * 128) = pack8(v0, v1);
                    if (bj == 1 && do_rope) {
                        rope8_apply(v0, v1, tc0, tc1);
                        *(u32x4*)(KPE + (size_t)row * 64 + wc * 32 + 8 * fq) = pack8(v0, v1);
                    }
                }
                if (u.pn == 0) {
                    float s = sq[0] + sq[1]; s += __shfl_xor(s, 16); s += __shfl_xor(s, 32);
                    if (fq == 0 && acc_on) atomicAdd(ssq_q + row, s);
                } else if (u.pn == 1) {
                    float s = sq[0]; s += __shfl_xor(s, 16); s += __shfl_xor(s, 32);
                    if (fq == 0 && acc_on) atomicAdd(ssq_kv + row, s);
                }
                asm volatile("" ::: "memory");
            }
    }
};
struct Epi2 {
    static constexpr bool PERM = true;
    bf16_t* Q; const float* ssq_q; const float* cs;
    DI void operator()(const f32x4 (&acc)[2][2][4][2], const pg8::Unit& u, int wr, int wc, int fr, int fq) const {
        const int row0 = u.pm * 256 + wr * 64 + fr, col0 = u.pn * 256 + wc * 32 + 8 * fq;
        float rsv[2][4];
#pragma unroll
        for (int ai = 0; ai < 2; ++ai)
#pragma unroll
            for (int m = 0; m < 4; ++m) rsv[ai][m] = ssq_q[row0 + ai * 128 + m * 16];
        const int d00 = col0 % 192, d01 = (col0 + 128) % 192;
        const int ropebj = d00 >= 128 ? 0 : (d01 >= 128 ? 1 : -1), ri0 = ((ropebj == 0 ? d00 : d01) - 128) >> 1;
        f32x4 tn0 = (f32x4){0.f, 0.f, 0.f, 0.f}, tn1 = tn0;
        if (ropebj >= 0) rope8_load(tn0, tn1, cs, (row0 & (SEQ - 1)) + NMETA, ri0);
#pragma unroll
        for (int ai = 0; ai < 2; ++ai)
#pragma unroll
            for (int m = 0; m < 4; ++m) {
                const int row = row0 + ai * 128 + m * 16;
                const float rs = rsqrtf(rsv[ai][m] * (1.0f / 256.0f) + EPS) * QSCALE;
                const f32x4 tc0 = tn0, tc1 = tn1;
                if (ropebj >= 0 && (ai * 4 + m) < 7) { const int rown = row0 + ((ai * 4 + m + 1) >> 2) * 128 + ((ai * 4 + m + 1) & 3) * 16; rope8_load(tn0, tn1, cs, (rown & (SEQ - 1)) + NMETA, ri0); }
#pragma unroll
                for (int bj = 0; bj < 2; ++bj) {
                    const int c0 = col0 + bj * 128;
                    f32x4 v0 = acc[ai][bj][m][0] * rs, v1 = acc[ai][bj][m][1] * rs;
                    if (ropebj == bj) rope8_apply(v0, v1, tc0, tc1);
                    *(u32x4*)(Q + (size_t)row * 768 + c0) = pack8(v0, v1);
                }
                asm volatile("" ::: "memory");
            }
    }
};
struct Epi3 {
    static constexpr bool PERM = false;
    float* O; const float* X; float* ssq; const float* fg; unsigned* cnt; bool fused; LAS float* part;
    DI void operator()(f32x4 (&acc)[2][2][4][2], const pg8::Unit& u, int wr, int wc, int fr, int fq) const {
        const int row0 = u.pm * 256 + wr * 64 + fr, col0 = u.pn * 256 + wc * 32 + 4 * fq;
        f32x4 xq[3][4];
#pragma unroll
        for (int pre = 0; pre < 3; ++pre) {
            const int rowp = row0 + (pre >> 2) * 128 + (pre & 3) * 16;
#pragma unroll
            for (int q = 0; q < 4; ++q) xq[pre][q] = __builtin_nontemporal_load((const f32x4*)(X + (size_t)rowp * DM + col0 + (q >> 1) * 128 + (q & 1) * 16));
        }
#pragma unroll
        for (int it = 0; it < 8; ++it) {
            const int ai = it >> 2, m = it & 3;
            const int row = row0 + ai * 128 + m * 16;
            f32x4 xc[4];
#pragma unroll
            for (int q = 0; q < 4; ++q) xc[q] = xq[it % 3][q];
            if (it + 3 < 8) {
                const int rown = row0 + ((it + 3) >> 2) * 128 + ((it + 3) & 3) * 16;
#pragma unroll
                for (int q = 0; q < 4; ++q) xq[it % 3][q] = __builtin_nontemporal_load((const f32x4*)(X + (size_t)rown * DM + col0 + (q >> 1) * 128 + (q & 1) * 16));
            }
            float s = 0.f;
#pragma unroll
            for (int bj = 0; bj < 2; ++bj)
#pragma unroll
                for (int n = 0; n < 2; ++n) {
                    const f32x4 v = acc[ai][bj][m][n] + xc[bj * 2 + n];
                    acc[ai][bj][m][n] = v;
                    if (!fused) *(f32x4*)(O + (size_t)row * DM + col0 + bj * 128 + n * 16) = v;
                    s += (v[0] * v[0] + v[1] * v[1]) + (v[2] * v[2] + v[3] * v[3]);
                }
            s += __shfl_xor(s, 16); s += __shfl_xor(s, 32);
            if (!fused) { if (fq == 0) atomicAdd(ssq + row, s); }
            else if (fq == 0) part[((wr * 8 + it) * 16 + fr) * 4 + wc] = s;
        }
        if (!fused) return;
        asm volatile("s_waitcnt lgkmcnt(0)" ::: "memory"); __builtin_amdgcn_s_barrier(); asm volatile("" ::: "memory");
        {
            const int l5 = fr + 16 * (fq & 1), itq = 2 * wc + (l5 >> 4);
            if (fq < 2) {
                const f32x4 pp = *(const LAS f32x4*)(part + ((wr * 8 + itq) * 16 + fr) * 4);
                atomicAdd(ssq + u.pm * 256 + wr * 64 + fr + (itq >> 2) * 128 + (itq & 3) * 16, (pp[0] + pp[1]) + (pp[2] + pp[3]));
            }
        }
        asm volatile("s_waitcnt vmcnt(0)" ::: "memory");
        unsigned* c = cnt + 64 * u.pm;
        if (fr == 0 && fq == 0) (void)__hip_atomic_fetch_add(c, 1u, __ATOMIC_RELAXED, __HIP_MEMORY_SCOPE_AGENT);
        asm volatile("" ::: "memory"); __builtin_amdgcn_s_barrier(); asm volatile("" ::: "memory");
        if (wr == 0 && wc == 0) {
            unsigned sp = 0;
            while (__hip_atomic_load(c, __ATOMIC_RELAXED, __HIP_MEMORY_SCOPE_AGENT) < 32u) { __builtin_amdgcn_s_sleep(1); if (++sp > (1u << 20)) break; }
        }
        asm volatile("" ::: "memory"); __builtin_amdgcn_s_barrier(); asm volatile("" ::: "memory");
        f32x4 g4[2][2];
#pragma unroll
        for (int bj = 0; bj < 2; ++bj)
#pragma unroll
            for (int n = 0; n < 2; ++n) g4[bj][n] = *(const f32x4*)(fg + col0 + bj * 128 + n * 16);
        float sv[2][4];
#pragma unroll
        for (int ai = 0; ai < 2; ++ai)
#pragma unroll
            for (int m = 0; m < 4; ++m) sv[ai][m] = __hip_atomic_load(ssq + row0 + ai * 128 + m * 16, __ATOMIC_RELAXED, __HIP_MEMORY_SCOPE_AGENT);
#pragma unroll
        for (int ai = 0; ai < 2; ++ai)
#pragma unroll
            for (int m = 0; m < 4; ++m) {
                const int row = row0 + ai * 128 + m * 16;
                const float rs = rsqrtf(sv[ai][m] * (1.0f / DM) + EPS);
#pragma unroll
                for (int bj = 0; bj < 2; ++bj)
#pragma unroll
                    for (int n = 0; n < 2; ++n)
                        *(f32x4*)(O + (size_t)row * DM + col0 + bj * 128 + n * 16) = acc[ai][bj][m][n] * rs * g4[bj][n];
                asm volatile("" ::: "memory");
            }
    }
};

template <int MODE>
DI void transpose_wtile(const Params& p, int n0, int k0) {
    const int lane = threadIdx.x & 63, k = k0 + lane;
    float g;
    if (MODE == 1) g = p.norm_g[k];
    if (MODE == 2) g = p.q_norm_g[k];
    if (MODE == 3) g = (k < 512 ? p.attn_out_g[k] : p.conv_out_g[k - 512]);
    if (MODE == 4) g = p.kv_norm_g[k];
    float v[16];
    const bool vec4 = (MODE == 3) || (MODE == 4) || (MODE == 1 && !(n0 >= C_KR && n0 < C_ZA) && !(n0 >= C_PAD && n0 < C_CONV));
    if (vec4) {
#pragma unroll
        for (int q = 0; q < 4; ++q) {
            const int n = n0 + 4 * q;
            f32x4 w;
            if (MODE == 1) w = *(const f32x4*)(p.w_in + (size_t)k * NIN + colmap1(n));
            if (MODE == 2) w = (f32x4){0.f, 0.f, 0.f, 0.f};
            if (MODE == 3) w = *(const f32x4*)(p.w_out + (size_t)k * DM + n);
            if (MODE == 4) w = *(const f32x4*)(p.w_kv_up + (size_t)k * 1024 + (n >> 7) * 256 + 128 + (n & 127));
#pragma unroll
            for (int j = 0; j < 4; ++j) v[4 * q + j] = w[j] * g;
        }
    } else {
#pragma unroll
        for (int i = 0; i < 16; ++i) {
            const int n = n0 + i;
            float w = 0.f;
            if (MODE == 1) { const int c = colmap1(n); if (c >= 0) w = p.w_in[(size_t)k * NIN + c]; }
            if (MODE == 2) w = p.w_q_up[(size_t)k * 768 + colmap2q(n)];
            v[i] = w * g;
        }
    }
    bf16_t* dst = (bf16_t*)(p.ws + (MODE == 1 ? WS_W1T : (MODE == 2 ? WS_W2T : (MODE == 3 ? WS_W3T : WS_WVT))));
    const int ldd = (MODE == 2) ? K2 : (MODE == 4 ? 128 : DM);
    const int kd = (MODE == 4) ? ((k & ~15) | ((k & 4) << 1) | ((k & 8) >> 1) | (k & 3)) : k;
#pragma unroll
    for (int i = 0; i < 16; ++i) dst[(size_t)(n0 + i) * ldd + kd] = f2bf(v[i]);
}
DI void wqk_task(const Params& p, int u) {
    const int lane = threadIdx.x & 63, k = (u & 3) * 64 + lane, hc = u >> 2, h = hc >> 5, c0 = (hc & 31) * 4;
    float a[4] = {0.f, 0.f, 0.f, 0.f};
    const float* qrow = p.w_q_up + (size_t)k * 768 + h * 192;
    const float* kb = p.w_kv_up + (size_t)c0 * 1024 + h * 256;
#pragma unroll 1
    for (int ec = 0; ec < 4; ++ec) {
        f32x4 q[8];
#pragma unroll
        for (int i = 0; i < 8; ++i) q[i] = *(const f32x4*)(qrow + ec * 32 + 4 * i);
#pragma unroll
        for (int ci = 0; ci < 4; ++ci)
#pragma unroll
            for (int i = 0; i < 8; ++i) {
                const f32x4 w = *(const f32x4*)(kb + (size_t)ci * 1024 + ec * 32 + 4 * i);
                a[ci] += (q[i][0] * w[0] + q[i][1] * w[1]) + (q[i][2] * w[2] + q[i][3] * w[3]);
            }
    }
    const float gq = p.q_norm_g[k];
    bf16_t* dst = (bf16_t*)(p.ws + WS_W2T);
#pragma unroll
    for (int ci = 0; ci < 4; ++ci) dst[(size_t)(h * 192 + c0 + ci) * K2 + k] = f2bf(a[ci] * gq * p.kv_norm_g[c0 + ci]);
}

DI void phase0(const Params& p) {
    const int tid = threadIdx.x, wid = __builtin_amdgcn_readfirstlane(tid >> 6), lane = tid & 63, nb = gridDim.x, bid = blockIdx.x;
    const int gw = bid * 2 + wid, nw = nb * 2;
    if (wid < 2) {
    {
        float* cs = (float*)(p.ws + WS_CS);
        for (int i = gw * 64 + lane; i < 2064 * 32; i += nw * 64) {
            const int pos = i >> 5, f = i & 31;
            const float ang = (float)pos * p.inv_freq[f];
            double rev = (double)ang * 0.15915494309189535; rev -= rint(rev);
            const float r = (float)rev;
            cs[2 * i] = __builtin_amdgcn_cosf(r); cs[2 * i + 1] = __builtin_amdgcn_sinf(r);
        }
        float* z = (float*)(p.ws + WS_SSQQ);
        for (int i = gw * 64 + lane; i < 3 * NTOK; i += nw * 64) z[i] = 0.f;
    }
    for (int u = gw; u < 512; u += nw) wqk_task(p, u);
    for (int r = gw; r < NMETA; r += nw) {
        bf16_t* MG = (bf16_t*)(p.ws + WS_MG); float ss = 0.f;
#pragma unroll
        for (int i = 0; i < 4; ++i) {
            const int k = lane * 4 + 256 * i;
            const f32x4 m = *(const f32x4*)(p.meta + r * DM + k), g = *(const f32x4*)(p.norm_g + k);
            ss += (m[0] * m[0] + m[1] * m[1]) + (m[2] * m[2] + m[3] * m[3]);
            u32x2 w; w.x = cvt_pk_bf16(m[0] * g[0], m[1] * g[1]); w.y = cvt_pk_bf16(m[2] * g[2], m[3] * g[3]);
            *(u32x2*)(MG + r * DM + k) = w;
        }
        ss = wave_sum(ss);
        if (lane == 0) ((float*)(p.ws + WS_RSTDM))[r] = rsqrtf(ss * (1.0f / DM) + EPS);
    }
    {
        constexpr int T1 = (N1 / 16) * (DM / 64), T2 = 16 * (K2 / 64), T3 = (DM / 16) * (DM / 64), T4 = 32 * 2;
        for (int t = gw; t < T1 + T2 + T3 + T4; t += nw) {
            if (t < T1) transpose_wtile<1>(p, (t >> 4) * 16, (t & 15) * 64);
            else if (t < T1 + T2) { const int u = t - T1, nt = u >> 2; transpose_wtile<2>(p, (nt >> 2) * 192 + 128 + (nt & 3) * 16, (u & 3) * 64); }
            else if (t < T1 + T2 + T3) { const int u = t - T1 - T2; transpose_wtile<3>(p, (u >> 4) * 16, (u & 15) * 64); }
            else { const int u = t - T1 - T2 - T3; transpose_wtile<4>(p, (u >> 1) * 16, (u & 1) * 64); }
        }
    }
    }
    {
        bf16_t* XB = (bf16_t*)(p.ws + WS_XB); float* rstd = (float*)(p.ws + WS_RSTDH);
        for (int kk = (wid >= 2 ? wid - 2 : 30 + wid); ; kk += (wid >= 2 ? 6 : 32)) {
            if (wid >= 2 && (kk % 32) >= 30) kk += 2;
            const int row = (bid + nb * kk) * 4;
            if (row >= NTOK) break;
            const float* xr = p.x + (size_t)row * DM;
            f32x4 v[16]; float s[4] = {0.f, 0.f, 0.f, 0.f};
#pragma unroll
            for (int i = 0; i < 16; ++i) v[i] = __builtin_nontemporal_load((const f32x4*)(xr + (i >> 2) * DM + lane * 4 + 256 * (i & 3)));
#pragma unroll
            for (int i = 0; i < 16; ++i) s[i >> 2] += (v[i][0] * v[i][0] + v[i][1] * v[i][1]) + (v[i][2] * v[i][2] + v[i][3] * v[i][3]);
#pragma unroll
            for (int i = 0; i < 16; ++i) { u32x2 w; w.x = cvt_pk_bf16(v[i][0], v[i][1]); w.y = cvt_pk_bf16(v[i][2], v[i][3]); *(u32x2*)(XB + (size_t)(row + (i >> 2)) * DM + lane * 4 + 256 * (i & 3)) = w; }
#pragma unroll
            for (int r = 0; r < 4; ++r) { const float t = wave_sum(s[r]); if (lane == 0) rstd[row + r] = rsqrtf(t * (1.0f / DM) + EPS); }
        }
    }
}

DI void meta_tile(const Params& p, int n0) {
    const int lane = threadIdx.x & 63, c = lane & 15, q = lane >> 4;
    const bf16_t* MG = (const bf16_t*)(p.ws + WS_MG) + c * DM + 8 * q;
    const bf16_t* W = (const bf16_t*)(p.ws + WS_W1T) + (size_t)(n0 + c) * DM + 8 * q;
    f32x4 acc = (f32x4){0.f, 0.f, 0.f, 0.f};
#pragma unroll 8
    for (int s = 0; s < 32; ++s) {
        const bf16x8 a = *(const bf16x8*)(MG + 32 * s), b = *(const bf16x8*)(W + 32 * s);
        acc = __builtin_amdgcn_mfma_f32_16x16x32_bf16(a, b, acc, 0, 0, 0);
    }
    const float* rsm = (const float*)(p.ws + WS_RSTDM);
    bf16_t* PM = (bf16_t*)(p.ws + WS_PMETA);
#pragma unroll
    for (int r = 0; r < 4; ++r) PM[(4 * q + r) * N1 + n0 + c] = f2bf(acc[r] * rsm[4 * q + r]);
}
DI void meta_inproj(const Params& p) {
    const int wid = __builtin_amdgcn_readfirstlane(threadIdx.x >> 6), nb = gridDim.x, bid = blockIdx.x;
    for (int ti = bid; ti < 192; ti += nb) if (((ti / nb) & 7) == wid) meta_tile(p, ti * 16);
}

constexpr int KROW = 400, VROW = 320;
constexpr int KBUF = 64 * KROW, VBUF = 64 * VROW;
constexpr int WVT_LDS = 2 * KBUF + 2 * VBUF, WVROW = 272;
DI s16x4 tr16(const LAS unsigned char* a) { return __builtin_amdgcn_ds_read_tr16_b64_v4i16((LAS s16x4*)a); }

struct TileRegs { u32x4 k[3]; float ssq; };
DI void attn_load_meta(const Params& p, TileRegs& R) {
    const int t = threadIdx.x, row = t >> 3, cg = t & 7;
    const u32x4 zero = (u32x4){0u, 0u, 0u, 0u};
    R.k[0] = zero; R.k[1] = zero; R.k[2] = zero; R.ssq = 0.f;
    if (row < NMETA) {
        const bf16_t* PM = (const bf16_t*)(p.ws + WS_PMETA) + row * N1;
        const u32x4 a = *(const u32x4*)(PM + C_CKV + cg * 8), b = *(const u32x4*)(PM + C_CKV + 64 + cg * 8), c = *(const u32x4*)(PM + C_KR + cg * 8);
        float ss = bf_lo(a.x) * bf_lo(a.x) + bf_hi(a.x) * bf_hi(a.x) + bf_lo(a.y) * bf_lo(a.y) + bf_hi(a.y) * bf_hi(a.y)
                 + bf_lo(a.z) * bf_lo(a.z) + bf_hi(a.z) * bf_hi(a.z) + bf_lo(a.w) * bf_lo(a.w) + bf_hi(a.w) * bf_hi(a.w)
                 + bf_lo(b.x) * bf_lo(b.x) + bf_hi(b.x) * bf_hi(b.x) + bf_lo(b.y) * bf_lo(b.y) + bf_hi(b.y) * bf_hi(b.y)
                 + bf_lo(b.z) * bf_lo(b.z) + bf_hi(b.z) * bf_hi(b.z) + bf_lo(b.w) * bf_lo(b.w) + bf_hi(b.w) * bf_hi(b.w);
        ss += __shfl_xor(ss, 1); ss += __shfl_xor(ss, 2); ss += __shfl_xor(ss, 4);
        R.k[0] = a; R.k[1] = b; R.ssq = ss;
        f32x4 t0, t1, v0, v1;
        rope8_load(t0, t1, (const float*)(p.ws + WS_CS), row, cg * 4);
        v0[0] = bf_lo(c.x); v0[1] = bf_hi(c.x); v0[2] = bf_lo(c.y); v0[3] = bf_hi(c.y); v1[0] = bf_lo(c.z); v1[1] = bf_hi(c.z); v1[2] = bf_lo(c.w); v1[3] = bf_hi(c.w);
        rope8_apply(v0, v1, t0, t1);
        R.k[2] = pack8(v0, v1);
    }
}
DI void attn_load_tile(TileRegs& R, const bf16_t* kvp, const bf16_t* kpp, const float* sqp) {
    R.k[0] = *(const u32x4*)(kvp); R.k[1] = *(const u32x4*)(kvp + 64); R.k[2] = *(const u32x4*)(kpp); R.ssq = *sqp;
}
DI u32x4 scale8(const u32x4& u, float rs) {
    u32x4 w;
    w.x = cvt_pk_bf16(bf_lo(u.x) * rs, bf_hi(u.x) * rs); w.y = cvt_pk_bf16(bf_lo(u.y) * rs, bf_hi(u.y) * rs);
    w.z = cvt_pk_bf16(bf_lo(u.z) * rs, bf_hi(u.z) * rs); w.w = cvt_pk_bf16(bf_lo(u.w) * rs, bf_hi(u.w) * rs);
    return w;
}
DI void attn_store_tile(const TileRegs& R, LAS unsigned char* kb, LAS unsigned char* vb) {
    const int t = threadIdx.x, row = t >> 3, cg = t & 7;
    LAS unsigned char* kd = kb + row * KROW + cg * 16; LAS unsigned char* vd = vb + row * VROW + cg * 16;
    const float rs = rsqrtf(R.ssq * (1.0f / 128.0f) + EPS);
    const u32x4 n0 = scale8(R.k[0], rs), n1 = scale8(R.k[1], rs);
    *(LAS u32x4*)(kd) = n0; *(LAS u32x4*)(kd + 128) = n1; *(LAS u32x4*)(kd + 256) = R.k[2];
    *(LAS u32x4*)(vd) = n0; *(LAS u32x4*)(vd + 128) = n1;
}

constexpr int WQROW = 272, WQHALF = 192 * WQROW;
DI void q_stage(const Params& p, LAS unsigned char* lds, int h) {
    const bf16_t* W = (const bf16_t*)(p.ws + WS_W2T) + (size_t)h * 192 * K2;
#pragma unroll
    for (int i = 0; i < 12; ++i) {
        const int id = threadIdx.x + 512 * i, row = id >> 5, cc = id & 31;
        *(LAS u32x4*)(lds + (cc >> 4) * WQHALF + row * WQROW + (cc & 15) * 16) = *(const u32x4*)(W + row * K2 + cc * 8);
    }
}
DI void q_block(const Params& p, const LAS unsigned char* lds, int b, int h, int j) {
    const int tid = threadIdx.x, wid = tid >> 6, lane = tid & 63, r = lane & 31, hh = lane >> 5;
    const int qs = 256 * j + 32 * wid + r;
    const size_t qrow = (size_t)b * SEQ + qs;
    const bf16_t* cqp = (const bf16_t*)(p.ws + WS_P) + qrow * N1 + 8 * hh;
    bf16x8 cq[16];
#pragma unroll
    for (int s = 0; s < 16; ++s) cq[s] = *(const bf16x8*)(cqp + 16 * s);
    const float rsq = rsqrtf(((const float*)(p.ws + WS_SSQQ))[qrow] * (1.0f / 256.0f) + EPS) * QSCALE;
    const float* cs = (const float*)(p.ws + WS_CS) + ((size_t)(qs + NMETA) * 32 + 2 * hh) * 2;
    bf16_t* Q = (bf16_t*)(p.ws + WS_Q) + qrow * 768 + h * 192 + 8 * hh;
    const LAS unsigned char* wl = lds + r * WQROW + 16 * hh;
    f32x16 acc[6];
#pragma unroll
    for (int dt = 0; dt < 6; ++dt)
#pragma unroll
        for (int i = 0; i < 16; ++i) acc[dt][i] = 0.f;
#pragma unroll
    for (int s = 0; s < 16; ++s) {
#pragma unroll
        for (int d3 = 0; d3 < 6; d3 += 3) {
            bf16x8 af[3];
#pragma unroll
            for (int dt = 0; dt < 3; ++dt) af[dt] = *(const LAS bf16x8*)(wl + (s >> 3) * WQHALF + (d3 + dt) * 32 * WQROW + (s & 7) * 32);
#pragma unroll
            for (int dt = 0; dt < 3; ++dt) acc[d3 + dt] = __builtin_amdgcn_mfma_f32_32x32x16_bf16(af[dt], cq[s], acc[d3 + dt], 0, 0, 0);
        }
    }
    asm volatile("" : "+v"(cs));
    f32x4 tr[8];
#pragma unroll
    for (int i = 0; i < 8; ++i) tr[i] = *(const f32x4*)(cs + (16 * (i >> 2) + 4 * (i & 3)) * 2);
#pragma unroll
    for (int dt = 0; dt < 6; ++dt)
#pragma unroll
        for (int gp = 0; gp < 2; ++gp) {
            u32x2 wq[2];
#pragma unroll
            for (int e = 0; e < 2; ++e) {
                const int g = 2 * gp + e;
                float v0 = acc[dt][4 * g] * rsq, v1 = acc[dt][4 * g + 1] * rsq, v2 = acc[dt][4 * g + 2] * rsq, v3 = acc[dt][4 * g + 3] * rsq;
                if (dt >= 4) {
                    const f32x4 t = tr[(dt - 4) * 4 + g];
                    const float a0 = v0 * t[0] - v1 * t[1], a1 = v1 * t[0] + v0 * t[1], a2 = v2 * t[2] - v3 * t[3], a3 = v3 * t[2] + v2 * t[3];
                    v0 = a0; v1 = a1; v2 = a2; v3 = a3;
                }
                wq[e].x = cvt_pk_bf16(v0, v1); wq[e].y = cvt_pk_bf16(v2, v3);
            }
            swap_x32(wq[0], wq[1]);
            u32x4 w; w.x = wq[0].x; w.y = wq[0].y; w.z = wq[1].x; w.w = wq[1].y;
            *(u32x4*)(Q + 32 * dt + 16 * gp) = w;
        }
}

DI void attn_block(const Params& p, LAS unsigned char* lds, int b, int h, int j) {
    const int tid = threadIdx.x, wid = tid >> 6, lane = tid & 63, r = lane & 31, hh = lane >> 5;
    const bf16_t* QB = (const bf16_t*)(p.ws + WS_Q);
    const int qs = 256 * j + 32 * wid + r;
    const size_t qrow = (size_t)b * SEQ + qs;
    bf16x8 qf[12];
#pragma unroll
    for (int s = 0; s < 12; ++s) qf[s] = *(const bf16x8*)(QB + qrow * 768 + h * 192 + 16 * s + 8 * hh);
    f32x16 o[4];
#pragma unroll
    for (int d = 0; d < 4; ++d)
#pragma unroll
        for (int i = 0; i < 16; ++i) o[d][i] = 0.f;
    float mrun = -1e30f, lrun = 0.f;
    const int ntile = 4 * j + 5;
    const int wave_rowmax = 256 * j + 32 * wid + 31, wave_rowmin = 256 * j + 32 * wid;
    TileRegs R;
    attn_load_meta(p, R);
    attn_store_tile(R, lds, lds + 2 * KBUF);
    __syncthreads();
    const bf16_t* kvu = (const bf16_t*)(p.ws + WS_P) + (size_t)b * SEQ * N1 + C_CKV;
    const float* squ = (const float*)(p.ws + WS_SSQKV) + (size_t)b * SEQ;
    const bf16_t* kpu = (const bf16_t*)(p.ws + WS_KPE) + (size_t)b * SEQ * 64;
    const unsigned okv = (unsigned)((tid >> 3) * N1 + (tid & 7) * 8), okp = (unsigned)((tid >> 3) * 64 + (tid & 7) * 8), osq = (unsigned)(tid >> 3);
    const int koff = r * KROW + 16 * hh;
    const int voff = (4 * hh + ((lane & 15) >> 2)) * VROW + (16 * ((lane >> 4) & 1) + 4 * (lane & 3)) * 2;
    for (int kt = 0; kt < ntile; ++kt) {
        const int cur = kt & 1;
        if (kt + 1 < ntile) { attn_load_tile(R, kvu + okv, kpu + okp, squ + osq); kvu += 64 * N1; kpu += 64 * 64; squ += 64; }
        const LAS unsigned char* kb = lds + cur * KBUF;
        const LAS unsigned char* vb = lds + 2 * KBUF + cur * VBUF;
        const int kbase = (kt - 1) * 64;
        const bool active = (kt == 0) || (kbase <= wave_rowmax);
        if (active) {
            const bool need_mask = (kt == 0) || (kbase + 63 > wave_rowmin);
#pragma unroll
            for (int sub = 0; sub < 2; ++sub) {
                f32x16 s;
#pragma unroll
                for (int i = 0; i < 16; ++i) s[i] = 0.f;
#pragma unroll
                for (int st = 0; st < 12; ++st) {
                    const bf16x8 kf = *(const LAS bf16x8*)(kb + koff + sub * 32 * KROW + st * 32);
                    s = __builtin_amdgcn_mfma_f32_32x32x16_bf16(kf, qf[st], s, 0, 0, 0);
                }
                __builtin_amdgcn_sched_group_barrier(0x100, 4, 0);
#pragma unroll
                for (int i = 0; i < 8; ++i) { __builtin_amdgcn_sched_group_barrier(0x008, 1, 0); __builtin_amdgcn_sched_group_barrier(0x100, 1, 0); }
                __builtin_amdgcn_sched_group_barrier(0x008, 4, 0);
                if (need_mask) {
#pragma unroll
                    for (int i = 0; i < 16; ++i) {
                        const int krow = 32 * sub + (i & 3) + 8 * (i >> 2) + 4 * hh;
                        const bool valid = (kt == 0) ? (krow < NMETA) : (kbase + krow <= qs);
                        s[i] = valid ? s[i] : -1e30f;
                    }
                }
                float mt = s[0];
#pragma unroll
                for (int i = 1; i < 16; ++i) mt = fmaxf(mt, s[i]);
                mt = max_x32(mt);
                const float mnew = fmaxf(mrun, mt);
                const float alpha = __builtin_amdgcn_exp2f(mrun - mnew);
                mrun = mnew;
                float ps = 0.f;
#pragma unroll
                for (int i = 0; i < 16; ++i) { s[i] = __builtin_amdgcn_exp2f(s[i] - mnew); ps += s[i]; }
                lrun = lrun * alpha + ps;
                if (__builtin_amdgcn_ballot_w64(alpha != 1.0f) != 0ull) {
#pragma unroll
                    for (int d = 0; d < 4; ++d)
#pragma unroll
                        for (int i = 0; i < 16; ++i) o[d][i] *= alpha;
                }
                bf16x8 pb[2];
#pragma unroll
                for (int s2 = 0; s2 < 2; ++s2) {
                    u32x4 w;
                    w.x = cvt_pk_bf16(s[8 * s2 + 0], s[8 * s2 + 1]); w.y = cvt_pk_bf16(s[8 * s2 + 2], s[8 * s2 + 3]);
                    w.z = cvt_pk_bf16(s[8 * s2 + 4], s[8 * s2 + 5]); w.w = cvt_pk_bf16(s[8 * s2 + 6], s[8 * s2 + 7]);
                    pb[s2] = __builtin_bit_cast(bf16x8, w);
                }
#pragma unroll
                for (int d = 0; d < 4; ++d)
#pragma unroll
                    for (int s2 = 0; s2 < 2; ++s2) {
                        const LAS unsigned char* a = vb + voff + (32 * sub + 16 * s2) * VROW + d * 64;
                        const s16x4 lo = tr16(a), hi = tr16(a + 8 * VROW);
                        const bf16x8 vf = __builtin_shufflevector(lo, hi, 0, 1, 2, 3, 4, 5, 6, 7);
                        o[d] = __builtin_amdgcn_mfma_f32_32x32x16_bf16(vf, pb[s2], o[d], 0, 0, 0);
                    }
                __builtin_amdgcn_sched_group_barrier(0x100, 4, 0);
#pragma unroll
                for (int i = 0; i < 6; ++i) { __builtin_amdgcn_sched_group_barrier(0x008, 1, 0); __builtin_amdgcn_sched_group_barrier(0x100, 2, 0); }
                __builtin_amdgcn_sched_group_barrier(0x008, 2, 0);
                __builtin_amdgcn_sched_barrier(0);
            }
        }
        if (kt + 1 < ntile) attn_store_tile(R, lds + (cur ^ 1) * KBUF, lds + 2 * KBUF + (cur ^ 1) * VBUF);
        __syncthreads();
    }
    const float ltot = sum_x32(lrun);
    const float inv = 1.0f / ltot;
    f32x16 o2[4];
#pragma unroll
    for (int d = 0; d < 4; ++d)
#pragma unroll
        for (int i = 0; i < 16; ++i) o2[d][i] = 0.f;
    const LAS unsigned char* WVL = lds + WVT_LDS + r * WVROW + 16 * hh;
    const bf16_t* P = (const bf16_t*)(p.ws + WS_P) + qrow * N1 + C_ZA + h * 128 + 8 * hh;
    asm volatile("" : "+v"(P));
    u32x4 zq[8];
#pragma unroll
    for (int i = 0; i < 8; ++i) zq[i] = *(const u32x4*)(P + 32 * (i >> 1) + 16 * (i & 1));
#pragma unroll
    for (int d = 0; d < 4; ++d)
#pragma unroll
        for (int s2 = 0; s2 < 2; ++s2) {
            u32x4 w;
            w.x = cvt_pk_bf16(o[d][8 * s2 + 0] * inv, o[d][8 * s2 + 1] * inv); w.y = cvt_pk_bf16(o[d][8 * s2 + 2] * inv, o[d][8 * s2 + 3] * inv);
            w.z = cvt_pk_bf16(o[d][8 * s2 + 4] * inv, o[d][8 * s2 + 5] * inv); w.w = cvt_pk_bf16(o[d][8 * s2 + 6] * inv, o[d][8 * s2 + 7] * inv);
            const bf16x8 pb = __builtin_bit_cast(bf16x8, w);
            const int c0 = 32 * d + 16 * s2;
#pragma unroll
            for (int dvt = 0; dvt < 4; ++dvt) {
                const bf16x8 af = *(const LAS bf16x8*)(WVL + dvt * 32 * WVROW + c0 * 2);
                o2[dvt] = __builtin_amdgcn_mfma_f32_32x32x16_bf16(af, pb, o2[dvt], 0, 0, 0);
            }
            asm volatile("" ::: "memory");
        }
    float ss = 0.f;
#pragma unroll
    for (int d = 0; d < 4; ++d)
#pragma unroll
        for (int i = 0; i < 16; ++i) ss += o2[d][i] * o2[d][i];
    ss = sum_x32(ss);
    const float rs = rsqrtf(ss * (1.0f / 128.0f) + EPS);
    bf16_t* MIX = (bf16_t*)(p.ws + WS_MIX) + qrow * DM + h * 128 + 8 * hh;
    asm volatile("" : "+v"(MIX));
#pragma unroll
    for (int d = 0; d < 4; ++d)
#pragma unroll
        for (int gp = 0; gp < 2; ++gp) {
            u32x2 za, zb, wa, wb;
            za.x = zq[2 * d + gp].x; za.y = zq[2 * d + gp].y; zb.x = zq[2 * d + gp].z; zb.y = zq[2 * d + gp].w;
            swap_x32(za, zb);
            const int g = 2 * gp;
            wa.x = cvt_pk_bf16(o2[d][4 * g + 0] * rs * silu(bf_lo(za.x)), o2[d][4 * g + 1] * rs * silu(bf_hi(za.x)));
            wa.y = cvt_pk_bf16(o2[d][4 * g + 2] * rs * silu(bf_lo(za.y)), o2[d][4 * g + 3] * rs * silu(bf_hi(za.y)));
            wb.x = cvt_pk_bf16(o2[d][4 * g + 4] * rs * silu(bf_lo(zb.x)), o2[d][4 * g + 5] * rs * silu(bf_hi(zb.x)));
            wb.y = cvt_pk_bf16(o2[d][4 * g + 6] * rs * silu(bf_lo(zb.y)), o2[d][4 * g + 7] * rs * silu(bf_hi(zb.y)));
            swap_x32(wa, wb);
            u32x4 w; w.x = wa.x; w.y = wa.y; w.z = wb.x; w.w = wb.y;
            *(u32x4*)(MIX + 32 * d + 16 * gp) = w;
        }
}

DI void load8(const bf16_t* src, float (&f)[8]) {
    const u32x4 u = *(const u32x4*)src;
    f[0] = bf_lo(u.x); f[1] = bf_hi(u.x); f[2] = bf_lo(u.y); f[3] = bf_hi(u.y); f[4] = bf_lo(u.z); f[5] = bf_hi(u.z); f[6] = bf_lo(u.w); f[7] = bf_hi(u.w);
}
DI void load_bchz(const bf16_t* pr, float (&b)[8], float (&ch)[8], float (&z)[8]) {
    const u32x4 bc0 = *(const u32x4*)(pr), hz0 = *(const u32x4*)(pr + 128), bc1 = *(const u32x4*)(pr + 8), hz1 = *(const u32x4*)(pr + 136);
    b[0] = bf_lo(bc0.x); b[1] = bf_hi(bc0.x); b[2] = bf_lo(bc0.y); b[3] = bf_hi(bc0.y); b[4] = bf_lo(bc1.x); b[5] = bf_hi(bc1.x); b[6] = bf_lo(bc1.y); b[7] = bf_hi(bc1.y);
    ch[0] = bf_lo(bc0.z) * bf_lo(hz0.x); ch[1] = bf_hi(bc0.z) * bf_hi(hz0.x); ch[2] = bf_lo(bc0.w) * bf_lo(hz0.y); ch[3] = bf_hi(bc0.w) * bf_hi(hz0.y);
    ch[4] = bf_lo(bc1.z) * bf_lo(hz1.x); ch[5] = bf_hi(bc1.z) * bf_hi(hz1.x); ch[6] = bf_lo(bc1.w) * bf_lo(hz1.y); ch[7] = bf_hi(bc1.w) * bf_hi(hz1.y);
    z[0] = bf_lo(hz0.z); z[1] = bf_hi(hz0.z); z[2] = bf_lo(hz0.w); z[3] = bf_hi(hz0.w); z[4] = bf_lo(hz1.z); z[5] = bf_hi(hz1.z); z[6] = bf_lo(hz1.w); z[7] = bf_hi(hz1.w);
}
DI void conv_fix(const Params& p, int run  ) {
    const int lane = threadIdx.x & 63, c0 = lane * 8;
    const int colb = C_CONV + (lane >> 3) * 256 + ((lane & 7) >> 1) * 32 + (lane & 1) * 16;
    const bf16_t* P = (const bf16_t*)(p.ws + WS_P) + colb; const bf16_t* PM = (const bf16_t*)(p.ws + WS_PMETA) + colb;
    bf16_t* MIX = (bf16_t*)(p.ws + WS_MIX);
    float w0[8], w1[8], w2[8];
#pragma unroll
    for (int j = 0; j < 8; ++j) { w0[j] = p.conv_w[c0 + j]; w1[j] = p.conv_w[512 + c0 + j]; w2[j] = p.conv_w[1024 + c0 + j]; }
    const int R0 = run * 64;
    const bool first = (R0 & (SEQ - 1)) == 0;
    float bq[8], zq[8], ch2[8], ch1[8];
    load_bchz(first ? PM + 14 * N1 : P + (size_t)(R0 - 2) * N1, bq, ch2, zq);
    load_bchz(first ? PM + 15 * N1 : P + (size_t)(R0 - 1) * N1, bq, ch1, zq);
#pragma unroll
    for (int i = 0; i < 2; ++i) {
        float b[8], ch0[8], z[8], y[8];
        load_bchz(P + (size_t)(R0 + i) * N1, b, ch0, z);
        float ss = 0.f;
#pragma unroll
        for (int j = 0; j < 8; ++j) { y[j] = b[j] * (w0[j] * ch2[j] + w1[j] * ch1[j] + w2[j] * ch0[j]); ss += y[j] * y[j]; ch2[j] = ch1[j]; ch1[j] = ch0[j]; }
        ss += __shfl_xor(ss, 1); ss += __shfl_xor(ss, 2); ss += __shfl_xor(ss, 4);
        const float rs = rsqrtf(ss * (1.0f / 64.0f) + EPS);
#pragma unroll
        for (int j = 0; j < 8; ++j) y[j] = y[j] * rs * silu(z[j]);
        u32x4 w; w.x = cvt_pk_bf16(y[0], y[1]); w.y = cvt_pk_bf16(y[2], y[3]); w.z = cvt_pk_bf16(y[4], y[5]); w.w = cvt_pk_bf16(y[6], y[7]);
        *(u32x4*)(MIX + (size_t)(R0 + i) * DM + 512 + c0) = w;
    }
}

__global__ void __launch_bounds__(512) fwd_megakernel(Params p) {
    extern __shared__ __attribute__((aligned(16))) unsigned char shm[];
    LAS unsigned char* lds = (LAS unsigned char*)shm;
    cg::grid_group grid = cg::this_grid();
    const int nb = gridDim.x, bid = blockIdx.x;
#define PH_ON(n) (p.ph_lo <= (n) && (n) < p.ph_hi)
#define PH_SYNC(n) if (p.ph_lo < (n) && (n) < p.ph_hi) xcd_barrier(xb)
    volatile LAS unsigned* xst = (volatile LAS unsigned*)(lds + 131072);
    if (threadIdx.x < 4) xst[threadIdx.x] = 0u;
    __syncthreads();
    const XcdBarrier xb = xcd_barrier_post((unsigned*)(p.ws + WS_BAR), xst);
    if (p.ph_hi > 1000) grid.sync();
    {
        if (PH_ON(0)) {
            for (int rep = 0; rep < REP0; ++rep) phase0(p);
        }
        PH_SYNC(1);
        for (int rep = 0; rep < REPSYNC; ++rep) xcd_barrier(xb);
        if (PH_ON(1)) {
            pg8::Gemm g; g.A = (const bf16_t*)(p.ws + WS_XB); g.Bt = (const bf16_t*)(p.ws + WS_W1T); g.lda = DM; g.ldb = DM; g.K = DM; g.nM = NTOK / 256; g.nN = N1 / 256; g.aoff_pn = 1 << 30; g.aoff_bytes = 0;
            pg8::StaticOrder S; S.init(g.nM, g.nN, nb, bid);
            meta_inproj(p);
            Epi1 E; E.P = (bf16_t*)(p.ws + WS_P); E.KPE = (bf16_t*)(p.ws + WS_KPE); E.rstd = (const float*)(p.ws + WS_RSTDH); E.ssq_q = (float*)(p.ws + WS_SSQQ); E.ssq_kv = (float*)(p.ws + WS_SSQKV); E.cs = (const float*)(p.ws + WS_CS);
            E.MIX = (bf16_t*)(p.ws + WS_MIX); E.conv_w = p.conv_w; E.part = (LAS float*)(lds + 131072 + 64);
            E.acc_on = true; pg8::gemm_phase<Epi1>(lds, g, S, E);
#if REP1 > 1
            __syncthreads(); E.acc_on = false; pg8::gemm_phase<Epi1>(lds, g, S, E);
#endif
        }
        PH_SYNC(3);
        if (PH_ON(3)) for (int rep = 0; rep < REP3; ++rep) {
            for (int run = bid + nb * (threadIdx.x >> 6); run < NTOK / 64; run += nb * 8) conv_fix(p, run);
            if (bid < 256) {
                const int it = bid, xcd = it & 7, slot = it >> 3;
                const int b = 2 * xcd + (slot >> 4), h = (slot >> 2) & 3, jp = slot & 3;
                q_stage(p, lds, h);
                __syncthreads();
                q_block(p, lds, b, h, 7 - jp);
                q_block(p, lds, b, h, jp);
                __syncthreads();
                {
                    const bf16_t* WVT = (const bf16_t*)(p.ws + WS_WVT) + (size_t)h * 128 * 128;
#pragma unroll
                    for (int i = 0; i < 4; ++i) { const int id = threadIdx.x + 512 * i, row = id >> 4, cc = id & 15; *(LAS u32x4*)(lds + WVT_LDS + row * WVROW + cc * 16) = *(const u32x4*)(WVT + row * 128 + cc * 8); }
                }
                attn_block(p, lds, b, h, 7 - jp);
                attn_block(p, lds, b, h, jp);
            }

        }
        PH_SYNC(4);
        if (PH_ON(4)) {
            pg8::Gemm g; g.A = (const bf16_t*)(p.ws + WS_MIX); g.Bt = (const bf16_t*)(p.ws + WS_W3T); g.lda = DM; g.ldb = DM; g.K = DM; g.nM = NTOK / 256; g.nN = DM / 256; g.aoff_pn = 1 << 30; g.aoff_bytes = 0;
            pg8::StaticOrder S; S.init(g.nM, g.nN, nb, bid);
            Epi3 E; E.O = p.out; E.X = p.x; E.ssq = (float*)(p.ws + WS_SSQO); E.fg = p.final_g; E.cnt = (unsigned*)(p.ws + WS_BAR + 16384); E.fused = (nb == 256); E.part = (LAS float*)(lds + 131072 + 64);
            pg8::gemm_phase<Epi3>(lds, g, S, E);
        }
        if (nb != 256) { PH_SYNC(5); }
        if (PH_ON(5) && nb != 256) for (int rep = REP5 - 1; rep >= 0; --rep) {
            const float* ssq = (const float*)(p.ws + WS_SSQO);
            const int wid = threadIdx.x >> 6, lane = threadIdx.x & 63;
            f32x4 g4[4];
#pragma unroll
            for (int i = 0; i < 4; ++i) g4[i] = *(const f32x4*)(p.final_g + lane * 4 + 256 * i);
            for (int row = bid * 8 + wid; row < NTOK; row += nb * 8) {
                const float rs = rsqrtf(ssq[row] * (1.0f / DM) + EPS);
                float* orow = p.out + (size_t)row * DM;
                float* drow = rep ? (float*)(p.ws + WS_P) + (size_t)row * DM : orow;
#pragma unroll
                for (int i = 0; i < 4; ++i) { f32x4 v = *(const f32x4*)(orow + lane * 4 + 256 * i); v = v * rs * g4[i]; *(f32x4*)(drow + lane * 4 + 256 * i) = v; }
            }
        }
    }
}

extern "C" void kernel_launch(void* const* d_in, const int* in_sizes, int n_in, void* d_out, int out_size, void* d_ws, size_t ws_size, hipStream_t stream) {
    constexpr int LDS = 131072 + 64 + 4096;
    static int grid_blocks = 0;
    if (!grid_blocks) {
        int dev = 0, cus = 0, per_cu = 0;
        hipGetDevice(&dev);
        hipDeviceGetAttribute(&cus, hipDeviceAttributeMultiprocessorCount, dev);
        if (hipFuncSetAttribute((const void*)fwd_megakernel, hipFuncAttributeMaxDynamicSharedMemorySize, LDS) != hipSuccess) fprintf(stderr, "hipFuncSetAttribute failed\n");
        hipOccupancyMaxActiveBlocksPerMultiprocessor(&per_cu, (const void*)fwd_megakernel, 512, LDS);
        if (per_cu < 1) fprintf(stderr, "occupancy query says %d blocks per CU\n", per_cu);
        grid_blocks = cus;
        if (cus != 256) fprintf(stderr, "this kernel is laid out for a 256-CU device (got %d)\n", cus);
        if (ws_size < WS_END) fprintf(stderr, "workspace too small: %zu < %zu\n", ws_size, (size_t)WS_END);
    }
    Params p{};
    p.x = (const float*)d_in[0]; p.meta = (const float*)d_in[1]; p.norm_g = (const float*)d_in[2]; p.w_in = (const float*)d_in[3];
    p.q_norm_g = (const float*)d_in[4]; p.w_q_up = (const float*)d_in[5]; p.kv_norm_g = (const float*)d_in[6]; p.w_kv_up = (const float*)d_in[7];
    p.conv_w = (const float*)d_in[8]; p.attn_out_g = (const float*)d_in[9]; p.conv_out_g = (const float*)d_in[10]; p.w_out = (const float*)d_in[11];
    p.final_g = (const float*)d_in[12];
    p.out = (float*)d_out; p.ws = (unsigned char*)d_ws;
    for (int i = 0; i < 32; ++i) p.inv_freq[i] = 1.0f / powf(10000.0f, (float)i / 32.0f);
    p.ph_lo = 0; p.ph_hi = 6;
    if (hipMemsetAsync((char*)d_ws + WS_BAR, 0, 65536, stream) != hipSuccess) fprintf(stderr, "memset of the barrier words failed\n");
    void* args[] = {&p};
    hipError_t e = hipLaunchCooperativeKernel((void*)fwd_megakernel, dim3(grid_blocks), dim3(512), args, LDS, stream);
    if (e != hipSuccess) fprintf(stderr, "cooperative launch failed: %s (grid %d)\n", hipGetErrorString(e), grid_blocks);
}
```

```cpp
#include <hip/hip_runtime.h>
#include <hip/hip_cooperative_groups.h>
#include <cstdio>
#include <cmath>
namespace cg = cooperative_groups;

#define LAS __attribute__((address_space(3)))
#define DI __device__ __forceinline__
typedef unsigned short bf16_t;
typedef short bf16x8 __attribute__((ext_vector_type(8)));
typedef short s16x4 __attribute__((ext_vector_type(4)));
typedef float f32x4 __attribute__((ext_vector_type(4)));
typedef float f32x2 __attribute__((ext_vector_type(2)));
typedef float f32x16 __attribute__((ext_vector_type(16)));
typedef unsigned u32x4 __attribute__((ext_vector_type(4)));
typedef unsigned u32x2 __attribute__((ext_vector_type(2)));

#define REP0 1
#define REP1 1
#define REP2 1
#define REP3 1
#define REP4 1
#define REP5 1
#define REPSYNC 0
constexpr int NTOK = 32768;
constexpr int SEQ = 2048;
constexpr int DM = 1024;
constexpr int NMETA = 16;
constexpr int NIN = 3008;
constexpr int N1 = 3072;
constexpr int N2 = 768;
constexpr int K2 = 256;
constexpr float EPS = 1e-6f;
constexpr float QSCALE = 0.07216878364870322f * 1.4426950408889634f;
constexpr int C_CKV = 256, C_KR = 384, C_ZA = 448, C_PAD = 960, C_CONV = 1024;

constexpr size_t WS_XB = 0;
constexpr size_t WS_MIX = WS_XB + (size_t)NTOK * DM * 2;
constexpr size_t WS_P = WS_MIX + (size_t)NTOK * DM * 2;
constexpr size_t WS_Q = WS_P + (size_t)NTOK * N1 * 2;
constexpr size_t WS_NKV = WS_Q + (size_t)NTOK * 768 * 2;
constexpr size_t WS_KPE = WS_NKV + (size_t)NTOK * 128 * 2;
constexpr size_t WS_W1T = WS_KPE + (size_t)NTOK * 64 * 2;
constexpr size_t WS_W2T = WS_W1T + (size_t)N1 * DM * 2;
constexpr size_t WS_W3T = WS_W2T + (size_t)N2 * K2 * 2;
constexpr size_t WS_PMETA = WS_W3T + (size_t)DM * DM * 2;
constexpr size_t WS_NKVM = WS_PMETA + (size_t)16 * N1 * 2;
constexpr size_t WS_KPEMETA = WS_NKVM + (size_t)16 * 128 * 2;
constexpr size_t WS_CS = WS_KPEMETA + (size_t)16 * 64 * 2;
constexpr size_t WS_RSTDH = WS_CS + (size_t)2064 * 32 * 8;
constexpr size_t WS_SSQQ = WS_RSTDH + (size_t)NTOK * 4;
constexpr size_t WS_SSQKV = WS_SSQQ + (size_t)NTOK * 4;
constexpr size_t WS_SSQO = WS_SSQKV + (size_t)NTOK * 4;
constexpr size_t WS_WVT = WS_SSQO + (size_t)NTOK * 4;
constexpr size_t WS_MG = WS_WVT + (size_t)512 * 128 * 2;
constexpr size_t WS_RSTDM = WS_MG + (size_t)16 * DM * 2;
constexpr size_t WS_BAR = WS_RSTDM + 256;
constexpr size_t WS_END = WS_BAR + 65536;

struct Params {
    const float* x; const float* meta; const float* norm_g; const float* w_in; const float* q_norm_g; const float* w_q_up;
    const float* kv_norm_g; const float* w_kv_up; const float* conv_w; const float* attn_out_g; const float* conv_out_g;
    const float* w_out; const float* final_g;
    float* out; unsigned char* ws;
    float inv_freq[32];
    int ph_lo, ph_hi;
};

DI unsigned cvt_pk_bf16(float lo, float hi) { unsigned r; asm volatile("v_cvt_pk_bf16_f32 %0, %1, %2" : "=v"(r) : "v"(lo), "v"(hi)); return r; }
DI float bf_lo(unsigned u) { return __uint_as_float(u << 16); }
DI float bf_hi(unsigned u) { return __uint_as_float(u & 0xffff0000u); }
DI float bf2f(bf16_t b) { return __uint_as_float(((unsigned)b) << 16); }
DI bf16_t f2bf(float f) { unsigned u = __float_as_uint(f); u += 0x7FFFu + ((u >> 16) & 1u); return (bf16_t)(u >> 16); }
DI float silu(float z) { return z * __builtin_amdgcn_rcpf(1.0f + __builtin_amdgcn_exp2f(-1.4426950408889634f * z)); }
DI float max_x32(float x) { const u32x2 r = __builtin_amdgcn_permlane32_swap(__float_as_uint(x), __float_as_uint(x), false, false); return fmaxf(__uint_as_float(r.x), __uint_as_float(r.y)); }
DI float sum_x32(float x) { const u32x2 r = __builtin_amdgcn_permlane32_swap(__float_as_uint(x), __float_as_uint(x), false, false); return __uint_as_float(r.x) + __uint_as_float(r.y); }
DI void swap_x32(u32x2& a, u32x2& b) {
    const u32x2 rx = __builtin_amdgcn_permlane32_swap(a.x, b.x, false, false), ry = __builtin_amdgcn_permlane32_swap(a.y, b.y, false, false);
    a.x = rx.x; b.x = rx.y; a.y = ry.x; b.y = ry.y;
}
DI float wave_sum(float v) {
#pragma unroll
    for (int o = 32; o >= 1; o >>= 1) v += __shfl_xor(v, o);
    return v;
}
DI int colmap1(int n) {
    if (n < C_KR) return n;
    if (n < C_ZA) { const int j = n - C_KR; return C_KR + (j >> 1) + 32 * (j & 1); }
    if (n < C_PAD) return n;
    if (n < C_CONV) return -1;
    const int u = n - C_CONV, g = u >> 8, cl = u & 255;
    const int t = ((cl >> 7) << 1) | ((cl >> 2) & 1), ch = ((cl >> 5) & 3) * 16 + ((cl >> 3) & 3) * 4 + (cl & 3);
    return 960 + 512 * t + 64 * g + ch;
}
DI int colmap2q(int n) {
    const int h = n / 192, d = n - h * 192;
    if (d < 128) return n;
    const int j = d - 128; return h * 192 + 128 + (j >> 1) + 32 * (j & 1);
}


#define XB_TMO      128
#define XB_XCNT(j)  (256  + 64 * (j))
#define XB_XSUB(j)  (1280 + 64 * (j))
#define XB_XGEN(j)  (2304 + 64 * (j))
#define XB_TOP      3328
#define XB_TOPGEN   3392
#define XCD_BAR_WORDS 3456
#define XB_SPIN_CAP (1u << 18)
DI unsigned xb_ld(unsigned* p)              { return __hip_atomic_load(p, __ATOMIC_RELAXED, __HIP_MEMORY_SCOPE_AGENT); }
DI unsigned xb_add(unsigned* p, unsigned v) { return __hip_atomic_fetch_add(p, v, __ATOMIC_RELAXED, __HIP_MEMORY_SCOPE_AGENT); }
DI unsigned xb_xcc_id() { return (unsigned)__builtin_amdgcn_s_getreg((3 << 11) | 20) & 0xFu; }
#define XB_SPIN(cond, bar) do { unsigned _sp = 0; while (cond) { __builtin_amdgcn_s_sleep(1); \
    if ((++_sp & 255u) == 0u) { if (xb_ld(&(bar)[XB_TMO])) break; if (_sp > XB_SPIN_CAP) { atomicAdd(&(bar)[XB_TMO], 1u); break; } } } } while (0)
struct XcdBarrier { unsigned* bar; unsigned x; volatile LAS unsigned* st; };
DI XcdBarrier xcd_barrier_post(unsigned* bar, volatile LAS unsigned* st) {
    XcdBarrier b; b.bar = bar; b.x = xb_xcc_id(); b.st = st;
    if (threadIdx.x == 0) (void)xb_add(&bar[XB_XCNT(b.x)], 1u);
    return b;
}
DI void xcd_barrier_complete(unsigned* bar, unsigned x, unsigned& nloc, unsigned& nx) {
    const unsigned G = gridDim.x * gridDim.y * gridDim.z;
    unsigned sum, cnt, mine, sp = 0u;
    for (;;) {
        sum = 0u; cnt = 0u; mine = 0u;
#pragma unroll
        for (unsigned j = 0; j < 16; ++j) { const unsigned c = xb_ld(&bar[XB_XCNT(j)]); sum += c; cnt += (c > 0u) ? 1u : 0u; mine = (j == x) ? c : mine; }
        if (sum == G) break;
        __builtin_amdgcn_s_sleep(1);
        if ((++sp & 255u) == 0u) { if (xb_ld(&bar[XB_TMO])) break; if (sp > XB_SPIN_CAP) { atomicAdd(&bar[XB_TMO], 1u); break; } }
    }
    nloc = mine > 0u ? mine : 1u; nx = cnt > 0u ? cnt : 1u;
}
DI void xcd_barrier(const XcdBarrier& b) {
    asm volatile("s_waitcnt vmcnt(0)" ::: "memory");
    __syncthreads();
    if (threadIdx.x == 0) {
        unsigned* bar = b.bar;
        __builtin_amdgcn_s_waitcnt(0);
        unsigned nloc = b.st[0], nx = b.st[1];
        if (nloc == 0u) { xcd_barrier_complete(bar, b.x, nloc, nx); b.st[0] = nloc; b.st[1] = nx; }
        const unsigned old = xb_add(&bar[XB_XSUB(b.x)], 1u);
        const unsigned gen = old / nloc;
        if (old + 1u == (gen + 1u) * nloc) {
            __builtin_amdgcn_fence(__ATOMIC_RELEASE, "agent");
            asm volatile("s_waitcnt vmcnt(0)" ::: "memory");
            const unsigned og = xb_add(&bar[XB_TOP], 1u);
            const unsigned tg = og / nx;
            if (og + 1u == (tg + 1u) * nx) xb_add(&bar[XB_TOPGEN], 1u);
            else XB_SPIN(xb_ld(&bar[XB_TOPGEN]) == tg, bar);
            __builtin_amdgcn_fence(__ATOMIC_ACQUIRE, "agent");
            xb_add(&bar[XB_XGEN(b.x)], 1u);
            asm volatile("s_waitcnt vmcnt(0)" ::: "memory");
        } else {
            XB_SPIN(xb_ld(&bar[XB_XGEN(b.x)]) == gen, bar);
            __builtin_amdgcn_fence(__ATOMIC_ACQUIRE, "agent");
            asm volatile("s_waitcnt vmcnt(0)" ::: "memory");
        }
    }
    __syncthreads();
}

namespace pg8 {
constexpr int BM = 256, BK = 64, HALF = 128, HTB = HALF * BK * 2, STAGE_BYTES = 8 * HTB, NXCD = 8, WGM = 8;
DI int lds_byte(int r, int c) { const int st = (r >> 4) * 2 + (c >> 5), rr = r & 15, cc = c & 31, ob = rr * 64 + cc * 2; return st * 1024 + (ob ^ (((ob >> 9) & 1) << 5)); }
DI void stage_rc(int b, int& R, int& C) { const int st = b / 1024, sb = b % 1024, swz = sb ^ (((sb >> 9) & 1) << 5); R = (st >> 1) * 16 + swz / 64; C = (st & 1) * 32 + (swz % 64) / 2; }
DI int perm32(int rho) { const int n = rho >> 4, i = rho & 15; return 8 * (i >> 2) + 4 * n + (i & 3); }
struct Unit { int pm, pn; };
struct Gemm { const bf16_t* A; const bf16_t* Bt; int lda, ldb, K, nM, nN; int aoff_pn, aoff_bytes; };
struct StaticOrder {
    int nM, nN, nwg, G, c;
    DI void init(int nM_, int nN_, int G_, int c_) { nM = nM_; nN = nN_; nwg = nM * nN; G = G_; c = c_; }
    DI bool next(int i, Unit& u) const {
        const long L = (long)i * G + c; if (L >= nwg) return false;
        int wgid = (int)L; { const int q = nwg / NXCD, r = nwg % NXCD, xcd = wgid % NXCD, off = wgid / NXCD; wgid = (xcd < r ? xcd * (q + 1) : r * (q + 1) + (xcd - r) * q) + off; }
        const int nig = WGM * nN, gid = wgid / nig, fm = gid * WGM, gsz = (nM - fm) < WGM ? (nM - fm) : WGM;
        u.pm = fm + ((wgid % nig) % gsz); u.pn = (wgid % nig) / gsz; return true;
    }
};

template <class Epi>
DI void gemm_phase(LAS unsigned char* lds, const Gemm g, const StaticOrder& S, const Epi& E) {
    const int tid = threadIdx.x, wid = __builtin_amdgcn_readfirstlane(tid >> 6), lane = tid & 63, wr = wid >> 2, wc = wid & 3, fr = lane & 15, fq = lane >> 4;
    int K = g.K; asm volatile("" : "+s"(K)); const int nt = K / BK;
    unsigned voffA[2], voffB[2];
#pragma unroll
    for (int i = 0; i < 2; ++i) { int R, C; stage_rc(tid * 16 + i * 8192, R, C); const int Rb = Epi::PERM ? ((R & ~31) + perm32(R & 31)) : R;
        voffA[i] = (unsigned)(R * g.lda + C) * 2u; voffB[i] = (unsigned)(Rb * g.ldb + C) * 2u; }
    const size_t kstep = (size_t)(BK * 2);
    const size_t hstepA = (size_t)HALF * g.lda * 2, hstepB = (size_t)HALF * g.ldb * 2;
    const size_t tstepA = 2 * hstepA, tstepB = 2 * hstepB;
    const unsigned ldsw = (unsigned)wid * 1024u;
    const int aoff = lds_byte(wr * 64 + fr, fq * 8), boff = lds_byte(wc * 32 + fr, fq * 8);
#define PG8_SA(b, h) (((b) * 2 + (h)) * HTB)
#define PG8_SB(b, h) ((4 + (b) * 2 + (h)) * HTB)
#define PG8_STAGE(bufoff, gbase, voff) do { _Pragma("unroll") for (int _i = 0; _i < 2; ++_i) \
        __builtin_amdgcn_global_load_lds((const unsigned*)((const char*)(gbase) + (voff)[_i]), (LAS unsigned*)(lds + (bufoff) + ldsw + _i * 8192), 16, 0, 0); } while (0)
#define PG8_LDA(dst, b, h) do { _Pragma("unroll") for (int m = 0; m < 4; ++m) _Pragma("unroll") for (int k = 0; k < 2; ++k) dst[m][k] = *(const LAS bf16x8*)(lds + PG8_SA(b, h) + aoff + m * 2048 + k * 1024); } while (0)
#define PG8_LDB(dst, b, h) do { _Pragma("unroll") for (int n = 0; n < 2; ++n) _Pragma("unroll") for (int k = 0; k < 2; ++k) dst[n][k] = *(const LAS bf16x8*)(lds + PG8_SB(b, h) + boff + n * 2048 + k * 1024); } while (0)
#define PG8_MMA(ai, bj, At, Bt) do { __builtin_amdgcn_s_setprio(1); _Pragma("unroll") for (int m = 0; m < 4; ++m) _Pragma("unroll") for (int n = 0; n < 2; ++n) _Pragma("unroll") for (int k = 0; k < 2; ++k) \
        acc[ai][bj][m][n] = __builtin_amdgcn_mfma_f32_16x16x32_bf16(Bt[n][k], At[m][k], acc[ai][bj][m][n], 0, 0, 0); __builtin_amdgcn_s_setprio(0); } while (0)
#define PG8_WAIT_V(n) asm volatile("s_waitcnt vmcnt(" #n ")" ::: "memory")
#define PG8_WAIT_L(n) asm volatile("s_waitcnt lgkmcnt(" #n ")" ::: "memory")
#define PG8_BAR __builtin_amdgcn_s_barrier()
#define PG8_SCHED __builtin_amdgcn_sched_barrier(0)
    Unit cur, nxt; int ui = 0;
    if (!S.next(0, cur)) return;
    f32x4 acc[2][2][4][2];
#pragma unroll
    for (int a = 0; a < 2; ++a)
#pragma unroll
        for (int b = 0; b < 2; ++b)
#pragma unroll
            for (int m = 0; m < 4; ++m)
#pragma unroll
                for (int n = 0; n < 2; ++n) acc[a][b][m][n] = (f32x4){0.f, 0.f, 0.f, 0.f};
    bf16x8 At[4][2], B0[2][2], B1[2][2];
    const char* cA = (const char*)g.A + (size_t)cur.pm * tstepA + (cur.pn >= g.aoff_pn ? g.aoff_bytes : 0);
    const char* cB = (const char*)g.Bt + (size_t)cur.pn * tstepB;
    PG8_STAGE(PG8_SB(0, 0), cB, voffB); PG8_STAGE(PG8_SA(0, 0), cA, voffA); PG8_STAGE(PG8_SB(0, 1), cB + hstepB, voffB); PG8_STAGE(PG8_SA(0, 1), cA + hstepA, voffA);
    if (wr == 1) PG8_BAR;
    PG8_WAIT_V(4); PG8_BAR;
    PG8_STAGE(PG8_SB(1, 0), cB + kstep, voffB); PG8_STAGE(PG8_SA(1, 0), cA + kstep, voffA); PG8_STAGE(PG8_SB(1, 1), cB + hstepB + kstep, voffB);
    PG8_WAIT_V(6); PG8_BAR;
    for (;;) {
        const bool has_next = S.next(ui + 1, nxt);
        const char* nA = has_next ? (const char*)g.A + (size_t)nxt.pm * tstepA + (nxt.pn >= g.aoff_pn ? g.aoff_bytes : 0) : cA;
        const char* nB = has_next ? (const char*)g.Bt + (size_t)nxt.pn * tstepB : cB;
        for (int t = 0; t < nt; t += 2) {
            const bool last = (t == nt - 2);
            const char* a1 = cA + (size_t)(t + 1) * kstep; const char* b1u = cB; (void)b1u;
            const char* a2 = last ? nA : cA + (size_t)(t + 2) * kstep; const char* b2 = last ? nB : cB + (size_t)(t + 2) * kstep;
            const char* a3 = a2 + kstep; const char* b3 = b2 + kstep;
            PG8_LDB(B0, 0, 0); PG8_SCHED; PG8_LDA(At, 0, 0); PG8_STAGE(PG8_SA(1, 1), a1 + hstepA, voffA);
            PG8_WAIT_L(8); PG8_BAR; PG8_WAIT_L(0); PG8_MMA(0, 0, At, B0); PG8_BAR; PG8_SCHED;
            PG8_LDB(B1, 0, 1); PG8_STAGE(PG8_SB(0, 0), b2, voffB);
            PG8_BAR; PG8_WAIT_L(0); PG8_MMA(0, 1, At, B1); PG8_BAR;
            PG8_LDA(At, 0, 1); PG8_STAGE(PG8_SA(0, 0), a2, voffA);
            PG8_BAR; PG8_WAIT_L(0); PG8_MMA(1, 0, At, B0); PG8_BAR; PG8_SCHED;
            PG8_STAGE(PG8_SB(0, 1), b2 + hstepB, voffB);
            PG8_WAIT_V(6); PG8_BAR; PG8_MMA(1, 1, At, B1); PG8_BAR;
            PG8_LDB(B0, 1, 0); PG8_SCHED; PG8_LDA(At, 1, 0); PG8_STAGE(PG8_SA(0, 1), a2 + hstepA, voffA);
            PG8_WAIT_L(8); PG8_BAR; PG8_WAIT_L(0); PG8_MMA(0, 0, At, B0); PG8_BAR; PG8_SCHED;
            PG8_LDB(B1, 1, 1); PG8_STAGE(PG8_SB(1, 0), b3, voffB);
            PG8_BAR; PG8_WAIT_L(0); PG8_MMA(0, 1, At, B1); PG8_BAR;
            PG8_LDA(At, 1, 1); PG8_STAGE(PG8_SA(1, 0), a3, voffA);
            PG8_BAR; PG8_WAIT_L(0); PG8_MMA(1, 0, At, B0); PG8_BAR; PG8_SCHED;
            PG8_STAGE(PG8_SB(1, 1), b3 + hstepB, voffB);
            PG8_WAIT_V(6); PG8_BAR; PG8_MMA(1, 1, At, B1); PG8_BAR;
        }
        E(acc, cur, wr, wc, fr, fq);
        if (!has_next) break;
#pragma unroll
        for (int a = 0; a < 2; ++a)
#pragma unroll
            for (int b = 0; b < 2; ++b)
#pragma unroll
                for (int m = 0; m < 4; ++m)
#pragma unroll
                    for (int n = 0; n < 2; ++n) acc[a][b][m][n] = (f32x4){0.f, 0.f, 0.f, 0.f};
        cur = nxt; cA = nA; cB = nB; ++ui;
    }
    PG8_WAIT_V(0);
    if (wr == 0) PG8_BAR;
    PG8_BAR;
#undef PG8_SA
#undef PG8_SB
#undef PG8_STAGE
#undef PG8_LDA
#undef PG8_LDB
#undef PG8_MMA
#undef PG8_WAIT_V
#undef PG8_WAIT_L
#undef PG8_BAR
#undef PG8_SCHED
}
}

DI float dpp_ror1(float x) { return __builtin_bit_cast(float, __builtin_amdgcn_update_dpp(0, __builtin_bit_cast(int, x), 0x121, 0xf, 0xf, false)); }
DI float dpp_ror2(float x) { return __builtin_bit_cast(float, __builtin_amdgcn_update_dpp(0, __builtin_bit_cast(int, x), 0x122, 0xf, 0xf, false)); }
DI void rope8_load(f32x4& t0, f32x4& t1, const float* cs  , int pos, int i0) {
    t0 = *(const f32x4*)(cs + ((size_t)pos * 32 + i0) * 2);
    t1 = *(const f32x4*)(cs + ((size_t)pos * 32 + i0 + 2) * 2);
}
DI void rope8_apply(f32x4& v0, f32x4& v1, const f32x4& t0, const f32x4& t1) {
    f32x4 o0, o1;
    o0[0] = v0[0] * t0[0] - v0[1] * t0[1]; o0[1] = v0[1] * t0[0] + v0[0] * t0[1];
    o0[2] = v0[2] * t0[2] - v0[3] * t0[3]; o0[3] = v0[3] * t0[2] + v0[2] * t0[3];
    o1[0] = v1[0] * t1[0] - v1[1] * t1[1]; o1[1] = v1[1] * t1[0] + v1[0] * t1[1];
    o1[2] = v1[2] * t1[2] - v1[3] * t1[3]; o1[3] = v1[3] * t1[2] + v1[2] * t1[3];
    v0 = o0; v1 = o1;
}
DI u32x4 pack8(const f32x4& v0, const f32x4& v1) {
    u32x4 w; w.x = cvt_pk_bf16(v0[0], v0[1]); w.y = cvt_pk_bf16(v0[2], v0[3]); w.z = cvt_pk_bf16(v1[0], v1[1]); w.w = cvt_pk_bf16(v1[2], v1[3]); return w;
}
DI float sq8(const f32x4& v0, const f32x4& v1) {
    return (v0[0] * v0[0] + v0[1] * v0[1]) + (v0[2] * v0[2] + v0[3] * v0[3]) + (v1[0] * v1[0] + v1[1] * v1[1]) + (v1[2] * v1[2] + v1[3] * v1[3]);
}

struct Epi1 {
    static constexpr bool PERM = true;
    DI void conv_epi(const f32x4 (&acc)[2][2][4][2], const pg8::Unit& u, int wr, int wc, int fr, int fq, const float (&rsv)[2][4]) const {
        const int row0 = u.pm * 256 + wr * 64 + fr, col0 = u.pn * 256 + wc * 32 + 8 * fq;
        const int chb = (u.pn - 4) * 64 + 16 * wc + 4 * fq;
        const f32x4 w0 = *(const f32x4*)(conv_w + chb), w1 = *(const f32x4*)(conv_w + 512 + chb), w2 = *(const f32x4*)(conv_w + 1024 + chb);
        f32x4 yc[8], p1 = (f32x4){0.f, 0.f, 0.f, 0.f}, p2 = p1;
#pragma unroll
        for (int it = 0; it < 8; ++it) {
            const int ai = it >> 2, m = it & 3, row = row0 + ai * 128 + m * 16;
            const float rs = rsv[ai][m];
            const f32x4 b = acc[ai][0][m][0] * rs, c = acc[ai][0][m][1] * rs, h = acc[ai][1][m][0] * rs;
            const f32x4 ch0 = c * h;
            f32x4 y1, y2;
#pragma unroll
            for (int j = 0; j < 4; ++j) { y1[j] = dpp_ror1(ch0[j]); y2[j] = dpp_ror2(ch0[j]); }
            const f32x4 v1 = (fr >= 1) ? y1 : p1, v2 = (fr >= 2) ? y2 : p2;
            p1 = y1; p2 = y2;
            const f32x4 y = b * (w0 * v2 + w1 * v1 + w2 * ch0);
            yc[it] = y;
            float ss = (y[0] * y[0] + y[1] * y[1]) + (y[2] * y[2] + y[3] * y[3]);
            ss += __shfl_xor(ss, 16); ss += __shfl_xor(ss, 32);
            if (fq == 0) part[((wr * 8 + it) * 16 + fr) * 4 + wc] = ss;
            if ((m == 0 && fr < 2) || (m == 3 && fr >= 14)) {
                const f32x4 z = acc[ai][1][m][1] * rs;
                *(u32x4*)(P + (size_t)row * N1 + col0) = pack8(b, c);
                *(u32x4*)(P + (size_t)row * N1 + col0 + 128) = pack8(h, z);
            }
        }
        asm volatile("s_waitcnt lgkmcnt(0)" ::: "memory"); __builtin_amdgcn_s_barrier(); asm volatile("" ::: "memory");
#pragma unroll
        for (int it = 0; it < 8; ++it) {
            const int ai = it >> 2, m = it & 3, row = row0 + ai * 128 + m * 16;
            const f32x4 pp = *(const LAS f32x4*)(part + ((wr * 8 + it) * 16 + fr) * 4);
            const float rsg = rsqrtf(((pp[0] + pp[1]) + (pp[2] + pp[3])) * (1.0f / 64.0f) + EPS);
            const f32x4 z = acc[ai][1][m][1] * rsv[ai][m];
            u32x2 w;
            w.x = cvt_pk_bf16(yc[it][0] * rsg * silu(z[0]), yc[it][1] * rsg * silu(z[1])); w.y = cvt_pk_bf16(yc[it][2] * rsg * silu(z[2]), yc[it][3] * rsg * silu(z[3]));
            if (!(m == 0 && fr < 2)) *(u32x2*)(MIX + (size_t)row * DM + 512 + chb) = w;
        }
    }
    bf16_t* P; bf16_t* KPE; const float* rstd; float* ssq_q; float* ssq_kv; const float* cs; bool acc_on;
    bf16_t* MIX; const float* conv_w; LAS float* part;
    DI void operator()(const f32x4 (&acc)[2][2][4][2], const pg8::Unit& u, int wr, int wc, int fr, int fq) const {
        const int row0 = u.pm * 256 + wr * 64 + fr, col0 = u.pn * 256 + wc * 32 + 8 * fq;
        float rsv[2][4];
#pragma unroll
        for (int ai = 0; ai < 2; ++ai)
#pragma unroll
            for (int m = 0; m < 4; ++m) rsv[ai][m] = rstd[row0 + ai * 128 + m * 16];
        if (u.pn >= 4) { conv_epi(acc, u, wr, wc, fr, fq, rsv); return; }
        const bool do_rope = (u.pn == 1) && (wc < 2);
        f32x4 tn0 = (f32x4){0.f, 0.f, 0.f, 0.f}, tn1 = tn0;
        if (do_rope) rope8_load(tn0, tn1, cs, (row0 & (SEQ - 1)) + NMETA, 16 * wc + 4 * fq);
#pragma unroll
        for (int ai = 0; ai < 2; ++ai)
#pragma unroll
            for (int m = 0; m < 4; ++m) {
                const int row = row0 + ai * 128 + m * 16;
                const float rs = rsv[ai][m];
                const f32x4 tc0 = tn0, tc1 = tn1;
                if (do_rope && (ai * 4 + m) < 7) { const int rown = row0 + ((ai * 4 + m + 1) >> 2) * 128 + ((ai * 4 + m + 1) & 3) * 16; rope8_load(tn0, tn1, cs, (rown & (SEQ - 1)) + NMETA, 16 * wc + 4 * fq); }
                float sq[2];
#pragma unroll
                for (int bj = 0; bj < 2; ++bj) {
                    f32x4 v0 = acc[ai][bj][m][0] * rs, v1 = acc[ai][bj][m][1] * rs;
                    sq[bj] = sq8(v0, v1);
                    *(u32x4*)(P + (size_t)row * N1 + col0 + bj * 128) = pack8(v0, v1);
                    if (bj == 1 && do_rope) {
                        rope8_apply(v0, v1, tc0, tc1);
                        *(u32x4*)(KPE + (size_t)row * 64 + wc * 32 + 8 * fq) = pack8(v0, v1);
                    }
                }
                if (u.pn == 0) {
                    float s = sq[0] + sq[1]; s += __shfl_xor(s, 16); s += __shfl_xor(s, 32);
                    if (fq == 0 && acc_on) atomicAdd(ssq_q + row, s);
                } else if (u.pn == 1) {
                    float s = sq[0]; s += __shfl_xor(s, 16); s += __shfl_xor(s, 32);
                    if (fq == 0 && acc_on) atomicAdd(ssq_kv + row, s);
                }
                asm volatile("" ::: "memory");
            }
    }
};
struct Epi2 {
    static constexpr bool PERM = true;
    bf16_t* Q; const float* ssq_q; const float* cs;
    DI void operator()(const f32x4 (&acc)[2][2][4][2], const pg8::Unit& u, int wr, int wc, int fr, int fq) const {
        const int row0 = u.pm * 256 + wr * 64 + fr, col0 = u.pn * 256 + wc * 32 + 8 * fq;
        float rsv[2][4];
#pragma unroll
        for (int ai = 0; ai < 2; ++ai)
#pragma unroll
            for (int m = 0; m < 4; ++m) rsv[ai][m] = ssq_q[row0 + ai * 128 + m * 16];
        const int d00 = col0 % 192, d01 = (col0 + 128) % 192;
        const int ropebj = d00 >= 128 ? 0 : (d01 >= 128 ? 1 : -1), ri0 = ((ropebj == 0 ? d00 : d01) - 128) >> 1;
        f32x4 tn0 = (f32x4){0.f, 0.f, 0.f, 0.f}, tn1 = tn0;
        if (ropebj >= 0) rope8_load(tn0, tn1, cs, (row0 & (SEQ - 1)) + NMETA, ri0);
#pragma unroll
        for (int ai = 0; ai < 2; ++ai)
#pragma unroll
            for (int m = 0; m < 4; ++m) {
                const int row = row0 + ai * 128 + m * 16;
                const float rs = rsqrtf(rsv[ai][m] * (1.0f / 256.0f) + EPS) * QSCALE;
                const f32x4 tc0 = tn0, tc1 = tn1;
                if (ropebj >= 0 && (ai * 4 + m) < 7) { const int rown = row0 + ((ai * 4 + m + 1) >> 2) * 128 + ((ai * 4 + m + 1) & 3) * 16; rope8_load(tn0, tn1, cs, (rown & (SEQ - 1)) + NMETA, ri0); }
#pragma unroll
                for (int bj = 0; bj < 2; ++bj) {
                    const int c0 = col0 + bj * 128;
                    f32x4 v0 = acc[ai][bj][m][0] * rs, v1 = acc[ai][bj][m][1] * rs;
                    if (ropebj == bj) rope8_apply(v0, v1, tc0, tc1);
                    *(u32x4*)(Q + (size_t)row * 768 + c0) = pack8(v0, v1);
                }
                asm volatile("" ::: "memory");
            }
    }
};
struct Epi3 {
    static constexpr bool PERM = false;
    float* O; const float* X; float* ssq; const float* fg; unsigned* cnt; bool fused; LAS float* part;
    DI void operator()(f32x4 (&acc)[2][2][4][2], const pg8::Unit& u, int wr, int wc, int fr, int fq) const {
        const int row0 = u.pm * 256 + wr * 64 + fr, col0 = u.pn * 256 + wc * 32 + 4 * fq;
        f32x4 xq[3][4];
#pragma unroll
        for (int pre = 0; pre < 3; ++pre) {
            const int rowp = row0 + (pre >> 2) * 128 + (pre & 3) * 16;
#pragma unroll
            for (int q = 0; q < 4; ++q) xq[pre][q] = __builtin_nontemporal_load((const f32x4*)(X + (size_t)rowp * DM + col0 + (q >> 1) * 128 + (q & 1) * 16));
        }
#pragma unroll
        for (int it = 0; it < 8; ++it) {
            const int ai = it >> 2, m = it & 3;
            const int row = row0 + ai * 128 + m * 16;
            f32x4 xc[4];
#pragma unroll
            for (int q = 0; q < 4; ++q) xc[q] = xq[it % 3][q];
            if (it + 3 < 8) {
                const int rown = row0 + ((it + 3) >> 2) * 128 + ((it + 3) & 3) * 16;
#pragma unroll
                for (int q = 0; q < 4; ++q) xq[it % 3][q] = __builtin_nontemporal_load((const f32x4*)(X + (size_t)rown * DM + col0 + (q >> 1) * 128 + (q & 1) * 16));
            }
            float s = 0.f;
#pragma unroll
            for (int bj = 0; bj < 2; ++bj)
#pragma unroll
                for (int n = 0; n < 2; ++n) {
                    const f32x4 v = acc[ai][bj][m][n] + xc[bj * 2 + n];
                    acc[ai][bj][m][n] = v;
                    if (!fused) *(f32x4*)(O + (size_t)row * DM + col0 + bj * 128 + n * 16) = v;
                    s += (v[0] * v[0] + v[1] * v[1]) + (v[2] * v[2] + v[3] * v[3]);
                }
            s += __shfl_xor(s, 16); s += __shfl_xor(s, 32);
            if (!fused) { if (fq == 0) atomicAdd(ssq + row, s); }
            else if (fq == 0) part[((wr * 8 + it) * 16 + fr) * 4 + wc] = s;
        }
        if (!fused) return;
        asm volatile("s_waitcnt lgkmcnt(0)" ::: "memory"); __builtin_amdgcn_s_barrier(); asm volatile("" ::: "memory");
        {
            const int l5 = fr + 16 * (fq & 1), itq = 2 * wc + (l5 >> 4);
            if (fq < 2) {
                const f32x4 pp = *(const LAS f32x4*)(part + ((wr * 8 + itq) * 16 + fr) * 4);
                atomicAdd(ssq + u.pm * 256 + wr * 64 + fr + (itq >> 2) * 128 + (itq & 3) * 16, (pp[0] + pp[1]) + (pp[2] + pp[3]));
            }
        }
        asm volatile("s_waitcnt vmcnt(0)" ::: "memory");
        unsigned* c = cnt + 64 * u.pm;
        if (fr == 0 && fq == 0) (void)__hip_atomic_fetch_add(c, 1u, __ATOMIC_RELAXED, __HIP_MEMORY_SCOPE_AGENT);
        asm volatile("" ::: "memory"); __builtin_amdgcn_s_barrier(); asm volatile("" ::: "memory");
        if (wr == 0 && wc == 0) {
            unsigned sp = 0;
            while (__hip_atomic_load(c, __ATOMIC_RELAXED, __HIP_MEMORY_SCOPE_AGENT) < 32u) { __builtin_amdgcn_s_sleep(1); if (++sp > (1u << 20)) break; }
        }
        asm volatile("" ::: "memory"); __builtin_amdgcn_s_barrier(); asm volatile("" ::: "memory");
        f32x4 g4[2][2];
#pragma unroll
        for (int bj = 0; bj < 2; ++bj)
#pragma unroll
            for (int n = 0; n < 2; ++n) g4[bj][n] = *(const f32x4*)(fg + col0 + bj * 128 + n * 16);
        float sv[2][4];
#pragma unroll
        for (int ai = 0; ai < 2; ++ai)
#pragma unroll
            for (int m = 0; m < 4; ++m) sv[ai][m] = __hip_atomic_load(ssq + row0 + ai * 128 + m * 16, __ATOMIC_RELAXED, __HIP_MEMORY_SCOPE_AGENT);
#pragma unroll
        for (int ai = 0; ai < 2; ++ai)
#pragma unroll
            for (int m = 0; m < 4; ++m) {
                const int row = row0 + ai * 128 + m * 16;
                const float rs = rsqrtf(sv[ai][m] * (1.0f / DM) + EPS);
#pragma unroll
                for (int bj = 0; bj < 2; ++bj)
#pragma unroll
                    for (int n = 0; n < 2; ++n)
                        *(f32x4*)(O + (size_t)row * DM + col0 + bj * 128 + n * 16) = acc[ai][bj][m][n] * rs * g4[bj][n];
                asm volatile("" ::: "memory");
            }
    }
};

template <int MODE>
DI void transpose_wtile(const Params& p, int n0, int k0) {
    const int lane = threadIdx.x & 63, k = k0 + lane;
    float g;
    if (MODE == 1) g = p.norm_g[k];
    if (MODE == 2) g = p.q_norm_g[k];
    if (MODE == 3) g = (k < 512 ? p.attn_out_g[k] : p.conv_out_g[k - 512]);
    if (MODE == 4) g = p.kv_norm_g[k];
    float v[16];
    const bool vec4 = (MODE == 3) || (MODE == 4) || (MODE == 1 && !(n0 >= C_KR && n0 < C_ZA) && !(n0 >= C_PAD && n0 < C_CONV));
    if (vec4) {
#pragma unroll
        for (int q = 0; q < 4; ++q) {
            const int n = n0 + 4 * q;
            f32x4 w;
            if (MODE == 1) w = *(const f32x4*)(p.w_in + (size_t)k * NIN + colmap1(n));
            if (MODE == 2) w = (f32x4){0.f, 0.f, 0.f, 0.f};
            if (MODE == 3) w = *(const f32x4*)(p.w_out + (size_t)k * DM + n);
            if (MODE == 4) w = *(const f32x4*)(p.w_kv_up + (size_t)k * 1024 + (n >> 7) * 256 + 128 + (n & 127));
#pragma unroll
            for (int j = 0; j < 4; ++j) v[4 * q + j] = w[j] * g;
        }
    } else {
#pragma unroll
        for (int i = 0; i < 16; ++i) {
            const int n = n0 + i;
            float w = 0.f;
            if (MODE == 1) { const int c = colmap1(n); if (c >= 0) w = p.w_in[(size_t)k * NIN + c]; }
            if (MODE == 2) w = p.w_q_up[(size_t)k * 768 + colmap2q(n)];
            v[i] = w * g;
        }
    }
    bf16_t* dst = (bf16_t*)(p.ws + (MODE == 1 ? WS_W1T : (MODE == 2 ? WS_W2T : (MODE == 3 ? WS_W3T : WS_WVT))));
    const int ldd = (MODE == 2) ? K2 : (MODE == 4 ? 128 : DM);
    const int kd = (MODE == 4) ? ((k & ~15) | ((k & 4) << 1) | ((k & 8) >> 1) | (k & 3)) : k;
#pragma unroll
    for (int i = 0; i < 16; ++i) dst[(size_t)(n0 + i) * ldd + kd] = f2bf(v[i]);
}
DI void wqk_task(const Params& p, int u) {
    const int lane = threadIdx.x & 63, k = (u & 3) * 64 + lane, hc = u >> 2, h = hc >> 5, c0 = (hc & 31) * 4;
    float a[4] = {0.f, 0.f, 0.f, 0.f};
    const float* qrow = p.w_q_up + (size_t)k * 768 + h * 192;
    const float* kb = p.w_kv_up + (size_t)c0 * 1024 + h * 256;
#pragma unroll 1
    for (int ec = 0; ec < 4; ++ec) {
        f32x4 q[8];
#pragma unroll
        for (int i = 0; i < 8; ++i) q[i] = *(const f32x4*)(qrow + ec * 32 + 4 * i);
#pragma unroll
        for (int ci = 0; ci < 4; ++ci)
#pragma unroll
            for (int i = 0; i < 8; ++i) {
                const f32x4 w = *(const f32x4*)(kb + (size_t)ci * 1024 + ec * 32 + 4 * i);
                a[ci] += (q[i][0] * w[0] + q[i][1] * w[1]) + (q[i][2] * w[2] + q[i][3] * w[3]);
            }
    }
    const float gq = p.q_norm_g[k];
    bf16_t* dst = (bf16_t*)(p.ws + WS_W2T);
#pragma unroll
    for (int ci = 0; ci < 4; ++ci) dst[(size_t)(h * 192 + c0 + ci) * K2 + k] = f2bf(a[ci] * gq * p.kv_norm_g[c0 + ci]);
}

DI void phase0(const Params& p) {
    const int tid = threadIdx.x, wid = __builtin_amdgcn_readfirstlane(tid >> 6), lane = tid & 63, nb = gridDim.x, bid = blockIdx.x;
    const int gw = bid * 2 + wid, nw = nb * 2;
    if (wid < 2) {
    {
        float* cs = (float*)(p.ws + WS_CS);
        for (int i = gw * 64 + lane; i < 2064 * 32; i += nw * 64) {
            const int pos = i >> 5, f = i & 31;
            const float ang = (float)pos * p.inv_freq[f];
            double rev = (double)ang * 0.15915494309189535; rev -= rint(rev);
            const float r = (float)rev;
            cs[2 * i] = __builtin_amdgcn_cosf(r); cs[2 * i + 1] = __builtin_amdgcn_sinf(r);
        }
        float* z = (float*)(p.ws + WS_SSQQ);
        for (int i = gw * 64 + lane; i < 3 * NTOK; i += nw * 64) z[i] = 0.f;
    }
    for (int u = gw; u < 512; u += nw) wqk_task(p, u);
    for (int r = gw; r < NMETA; r += nw) {
        bf16_t* MG = (bf16_t*)(p.ws + WS_MG); float ss = 0.f;
#pragma unroll
        for (int i = 0; i < 4; ++i) {
            const int k = lane * 4 + 256 * i;
            const f32x4 m = *(const f32x4*)(p.meta + r * DM + k), g = *(const f32x4*)(p.norm_g + k);
            ss += (m[0] * m[0] + m[1] * m[1]) + (m[2] * m[2] + m[3] * m[3]);
            u32x2 w; w.x = cvt_pk_bf16(m[0] * g[0], m[1] * g[1]); w.y = cvt_pk_bf16(m[2] * g[2], m[3] * g[3]);
            *(u32x2*)(MG + r * DM + k) = w;
        }
        ss = wave_sum(ss);
        if (lane == 0) ((float*)(p.ws + WS_RSTDM))[r] = rsqrtf(ss * (1.0f / DM) + EPS);
    }
    {
        constexpr int T1 = (N1 / 16) * (DM / 64), T2 = 16 * (K2 / 64), T3 = (DM / 16) * (DM / 64), T4 = 32 * 2;
        for (int t = gw; t < T1 + T2 + T3 + T4; t += nw) {
            if (t < T1) transpose_wtile<1>(p, (t >> 4) * 16, (t & 15) * 64);
            else if (t < T1 + T2) { const int u = t - T1, nt = u >> 2; transpose_wtile<2>(p, (nt >> 2) * 192 + 128 + (nt & 3) * 16, (u & 3) * 64); }
            else if (t < T1 + T2 + T3) { const int u = t - T1 - T2; transpose_wtile<3>(p, (u >> 4) * 16, (u & 15) * 64); }
            else { const int u = t - T1 - T2 - T3; transpose_wtile<4>(p, (u >> 1) * 16, (u & 1) * 64); }
        }
    }
    }
    {
        bf16_t* XB = (bf16_t*)(p.ws + WS_XB); float* rstd = (float*)(p.ws + WS_RSTDH);
        for (int kk = (wid >= 2 ? wid - 2 : 30 + wid); ; kk += (wid >= 2 ? 6 : 32)) {
            if (wid >= 2 && (kk % 32) >= 30) kk += 2;
            const int row = (bid + nb * kk) * 4;
            if (row >= NTOK) break;
            const float* xr = p.x + (size_t)row * DM;
            f32x4 v[16]; float s[4] = {0.f, 0.f, 0.f, 0.f};
#pragma unroll
            for (int i = 0; i < 16; ++i) v[i] = __builtin_nontemporal_load((const f32x4*)(xr + (i >> 2) * DM + lane * 4 + 256 * (i & 3)));
#pragma unroll
            for (int i = 0; i < 16; ++i) s[i >> 2] += (v[i][0] * v[i][0] + v[i][1] * v[i][1]) + (v[i][2] * v[i][2] + v[i][3] * v[i][3]);
#pragma unroll
            for (int i = 0; i < 16; ++i) { u32x2 w; w.x = cvt_pk_bf16(v[i][0], v[i][1]); w.y = cvt_pk_bf16(v[i][2], v[i][3]); *(u32x2*)(XB + (size_t)(row + (i >> 2)) * DM + lane * 4 + 256 * (i & 3)) = w; }
#pragma unroll
            for (int r = 0; r < 4; ++r) { const float t = wave_sum(s[r]); if (lane == 0) rstd[row + r] = rsqrtf(t * (1.0f / DM) + EPS); }
        }
    }
}

DI void meta_tile(const Params& p, int n0) {
    const int lane = threadIdx.x & 63, c = lane & 15, q = lane >> 4;
    const bf16_t* MG = (const bf16_t*)(p.ws + WS_MG) + c * DM + 8 * q;
    const bf16_t* W = (const bf16_t*)(p.ws + WS_W1T) + (size_t)(n0 + c) * DM + 8 * q;
    f32x4 acc = (f32x4){0.f, 0.f, 0.f, 0.f};
#pragma unroll 8
    for (int s = 0; s < 32; ++s) {
        const bf16x8 a = *(const bf16x8*)(MG + 32 * s), b = *(const bf16x8*)(W + 32 * s);
        acc = __builtin_amdgcn_mfma_f32_16x16x32_bf16(a, b, acc, 0, 0, 0);
    }
    const float* rsm = (const float*)(p.ws + WS_RSTDM);
    bf16_t* PM = (bf16_t*)(p.ws + WS_PMETA);
#pragma unroll
    for (int r = 0; r < 4; ++r) PM[(4 * q + r) * N1 + n0 + c] = f2bf(acc[r] * rsm[4 * q + r]);
}
DI void meta_inproj(const Params& p) {
    const int wid = __builtin_amdgcn_readfirstlane(threadIdx.x >> 6), nb = gridDim.x, bid = blockIdx.x;
    for (int ti = bid; ti < 192; ti += nb) if (((ti / nb) & 7) == wid) meta_tile(p, ti * 16);
}

constexpr int KROW = 400, VROW = 320;
constexpr int KBUF = 64 * KROW, VBUF = 64 * VROW;
constexpr int WVT_LDS = 2 * KBUF + 2 * VBUF, WVROW = 272;
DI s16x4 tr16(const LAS unsigned char* a) { return __builtin_amdgcn_ds_read_tr16_b64_v4i16((LAS s16x4*)a); }

struct TileRegs { u32x4 k[3]; float ssq; };
DI void attn_load_meta(const Params& p, TileRegs& R) {
    const int t = threadIdx.x, row = t >> 3, cg = t & 7;
    const u32x4 zero = (u32x4){0u, 0u, 0u, 0u};
    R.k[0] = zero; R.k[1] = zero; R.k[2] = zero; R.ssq = 0.f;
    if (row < NMETA) {
        const bf16_t* PM = (const bf16_t*)(p.ws + WS_PMETA) + row * N1;
        const u32x4 a = *(const u32x4*)(PM + C_CKV + cg * 8), b = *(const u32x4*)(PM + C_CKV + 64 + cg * 8), c = *(const u32x4*)(PM + C_KR + cg * 8);
        float ss = bf_lo(a.x) * bf_lo(a.x) + bf_hi(a.x) * bf_hi(a.x) + bf_lo(a.y) * bf_lo(a.y) + bf_hi(a.y) * bf_hi(a.y)
                 + bf_lo(a.z) * bf_lo(a.z) + bf_hi(a.z) * bf_hi(a.z) + bf_lo(a.w) * bf_lo(a.w) + bf_hi(a.w) * bf_hi(a.w)
                 + bf_lo(b.x) * bf_lo(b.x) + bf_hi(b.x) * bf_hi(b.x) + bf_lo(b.y) * bf_lo(b.y) + bf_hi(b.y) * bf_hi(b.y)
                 + bf_lo(b.z) * bf_lo(b.z) + bf_hi(b.z) * bf_hi(b.z) + bf_lo(b.w) * bf_lo(b.w) + bf_hi(b.w) * bf_hi(b.w);
        ss += __shfl_xor(ss, 1); ss += __shfl_xor(ss, 2); ss += __shfl_xor(ss, 4);
        R.k[0] = a; R.k[1] = b; R.ssq = ss;
        f32x4 t0, t1, v0, v1;
        rope8_load(t0, t1, (const float*)(p.ws + WS_CS), row, cg * 4);
        v0[0] = bf_lo(c.x); v0[1] = bf_hi(c.x); v0[2] = bf_lo(c.y); v0[3] = bf_hi(c.y); v1[0] = bf_lo(c.z); v1[1] = bf_hi(c.z); v1[2] = bf_lo(c.w); v1[3] = bf_hi(c.w);
        rope8_apply(v0, v1, t0, t1);
        R.k[2] = pack8(v0, v1);
    }
}
DI void attn_load_tile(TileRegs& R, const bf16_t* kvp, const bf16_t* kpp, const float* sqp) {
    R.k[0] = *(const u32x4*)(kvp); R.k[1] = *(const u32x4*)(kvp + 64); R.k[2] = *(const u32x4*)(kpp); R.ssq = *sqp;
}
DI u32x4 scale8(const u32x4& u, float rs) {
    u32x4 w;
    w.x = cvt_pk_bf16(bf_lo(u.x) * rs, bf_hi(u.x) * rs); w.y = cvt_pk_bf16(bf_lo(u.y) * rs, bf_hi(u.y) * rs);
    w.z = cvt_pk_bf16(bf_lo(u.z) * rs, bf_hi(u.z) * rs); w.w = cvt_pk_bf16(bf_lo(u.w) * rs, bf_hi(u.w) * rs);
    return w;
}
DI void attn_store_tile(const TileRegs& R, LAS unsigned char* kb, LAS unsigned char* vb) {
    const int t = threadIdx.x, row = t >> 3, cg = t & 7;
    LAS unsigned char* kd = kb + row * KROW + cg * 16; LAS unsigned char* vd = vb + row * VROW + cg * 16;
    const float rs = rsqrtf(R.ssq * (1.0f / 128.0f) + EPS);
    const u32x4 n0 = scale8(R.k[0], rs), n1 = scale8(R.k[1], rs);
    *(LAS u32x4*)(kd) = n0; *(LAS u32x4*)(kd + 128) = n1; *(LAS u32x4*)(kd + 256) = R.k[2];
    *(LAS u32x4*)(vd) = n0; *(LAS u32x4*)(vd + 128) = n1;
}

constexpr int WQROW = 272, WQHALF = 192 * WQROW;
DI void q_stage_load(const Params& p, int h, u32x4 (&wreg)[12]) {
    const bf16_t* W = (const bf16_t*)(p.ws + WS_W2T) + (size_t)h * 192 * K2;
#pragma unroll
    for (int i = 0; i < 12; ++i) { const int id = threadIdx.x + 512 * i, row = id >> 5, cc = id & 31; wreg[i] = *(const u32x4*)(W + row * K2 + cc * 8); }
}
DI void q_stage_store(LAS unsigned char* lds, const u32x4 (&wreg)[12]) {
#pragma unroll
    for (int i = 0; i < 12; ++i) { const int id = threadIdx.x + 512 * i, row = id >> 5, cc = id & 31; *(LAS u32x4*)(lds + (cc >> 4) * WQHALF + row * WQROW + (cc & 15) * 16) = wreg[i]; }
}
DI void q_block(const Params& p, const LAS unsigned char* lds, int b, int h, int j) {
    const int tid = threadIdx.x, wid = tid >> 6, lane = tid & 63, r = lane & 31, hh = lane >> 5;
    const int qs = 256 * j + 32 * wid + r;
    const size_t qrow = (size_t)b * SEQ + qs;
    const bf16_t* cqp = (const bf16_t*)(p.ws + WS_P) + qrow * N1 + 8 * hh;
    bf16x8 cq[16];
#pragma unroll
    for (int s = 0; s < 16; ++s) cq[s] = *(const bf16x8*)(cqp + 16 * s);
    const float rsq = rsqrtf(((const float*)(p.ws + WS_SSQQ))[qrow] * (1.0f / 256.0f) + EPS) * QSCALE;
    const float* cs = (const float*)(p.ws + WS_CS) + ((size_t)(qs + NMETA) * 32 + 2 * hh) * 2;
    bf16_t* Q = (bf16_t*)(p.ws + WS_Q) + qrow * 768 + h * 192 + 8 * hh;
    const LAS unsigned char* wl = lds + r * WQROW + 16 * hh;
    f32x16 acc[6];
#pragma unroll
    for (int dt = 0; dt < 6; ++dt)
#pragma unroll
        for (int i = 0; i < 16; ++i) acc[dt][i] = 0.f;
#pragma unroll
    for (int s = 0; s < 16; ++s) {
#pragma unroll
        for (int d3 = 0; d3 < 6; d3 += 3) {
            bf16x8 af[3];
#pragma unroll
            for (int dt = 0; dt < 3; ++dt) af[dt] = *(const LAS bf16x8*)(wl + (s >> 3) * WQHALF + (d3 + dt) * 32 * WQROW + (s & 7) * 32);
#pragma unroll
            for (int dt = 0; dt < 3; ++dt) acc[d3 + dt] = __builtin_amdgcn_mfma_f32_32x32x16_bf16(af[dt], cq[s], acc[d3 + dt], 0, 0, 0);
        }
    }
    asm volatile("" : "+v"(cs));
    f32x4 tr[8];
#pragma unroll
    for (int i = 0; i < 8; ++i) tr[i] = *(const f32x4*)(cs + (16 * (i >> 2) + 4 * (i & 3)) * 2);
#pragma unroll
    for (int dt = 0; dt < 6; ++dt)
#pragma unroll
        for (int gp = 0; gp < 2; ++gp) {
            u32x2 wq[2];
#pragma unroll
            for (int e = 0; e < 2; ++e) {
                const int g = 2 * gp + e;
                float v0 = acc[dt][4 * g] * rsq, v1 = acc[dt][4 * g + 1] * rsq, v2 = acc[dt][4 * g + 2] * rsq, v3 = acc[dt][4 * g + 3] * rsq;
                if (dt >= 4) {
                    const f32x4 t = tr[(dt - 4) * 4 + g];
                    const float a0 = v0 * t[0] - v1 * t[1], a1 = v1 * t[0] + v0 * t[1], a2 = v2 * t[2] - v3 * t[3], a3 = v3 * t[2] + v2 * t[3];
                    v0 = a0; v1 = a1; v2 = a2; v3 = a3;
                }
                wq[e].x = cvt_pk_bf16(v0, v1); wq[e].y = cvt_pk_bf16(v2, v3);
            }
            swap_x32(wq[0], wq[1]);
            u32x4 w; w.x = wq[0].x; w.y = wq[0].y; w.z = wq[1].x; w.w = wq[1].y;
            *(u32x4*)(Q + 32 * dt + 16 * gp) = w;
        }
}

DI void attn_block(const Params& p, LAS unsigned char* lds, int b, int h, int j) {
    const int tid = threadIdx.x, wid = tid >> 6, lane = tid & 63, r = lane & 31, hh = lane >> 5;
    const bf16_t* QB = (const bf16_t*)(p.ws + WS_Q);
    const int qs = 256 * j + 32 * wid + r;
    const size_t qrow = (size_t)b * SEQ + qs;
    bf16x8 qf[12];
#pragma unroll
    for (int s = 0; s < 12; ++s) qf[s] = *(const bf16x8*)(QB + qrow * 768 + h * 192 + 16 * s + 8 * hh);
    f32x16 o[4];
#pragma unroll
    for (int d = 0; d < 4; ++d)
#pragma unroll
        for (int i = 0; i < 16; ++i) o[d][i] = 0.f;
    float mrun = -1e30f, lrun = 0.f;
    const int ntile = 4 * j + 5;
    const int wave_rowmax = 256 * j + 32 * wid + 31, wave_rowmin = 256 * j + 32 * wid;
    TileRegs R;
    attn_load_meta(p, R);
    attn_store_tile(R, lds, lds + 2 * KBUF);
    __syncthreads();
    const bf16_t* kvp = (const bf16_t*)(p.ws + WS_P) + ((size_t)b * SEQ + (tid >> 3)) * N1 + C_CKV + (tid & 7) * 8;
    const float* sqp = (const float*)(p.ws + WS_SSQKV) + (size_t)b * SEQ + (tid >> 3);
    const bf16_t* kpp = (const bf16_t*)(p.ws + WS_KPE) + ((size_t)b * SEQ + (tid >> 3)) * 64 + (tid & 7) * 8;
    const int koff = r * KROW + 16 * hh;
    const int voff = (4 * hh + ((lane & 15) >> 2)) * VROW + (16 * ((lane >> 4) & 1) + 4 * (lane & 3)) * 2;
    for (int kt = 0; kt < ntile; ++kt) {
        const int cur = kt & 1;
        if (kt + 1 < ntile) { attn_load_tile(R, kvp, kpp, sqp); kvp += 64 * N1; kpp += 64 * 64; sqp += 64; }
        const LAS unsigned char* kb = lds + cur * KBUF;
        const LAS unsigned char* vb = lds + 2 * KBUF + cur * VBUF;
        const int kbase = (kt - 1) * 64;
        const bool active = (kt == 0) || (kbase <= wave_rowmax);
        if (active) {
            const bool need_mask = (kt == 0) || (kbase + 63 > wave_rowmin);
#pragma unroll
            for (int sub = 0; sub < 2; ++sub) {
                f32x16 s;
#pragma unroll
                for (int i = 0; i < 16; ++i) s[i] = 0.f;
#pragma unroll
                for (int st = 0; st < 12; ++st) {
                    const bf16x8 kf = *(const LAS bf16x8*)(kb + koff + sub * 32 * KROW + st * 32);
                    s = __builtin_amdgcn_mfma_f32_32x32x16_bf16(kf, qf[st], s, 0, 0, 0);
                }
                __builtin_amdgcn_sched_group_barrier(0x100, 4, 0);
#pragma unroll
                for (int i = 0; i < 8; ++i) { __builtin_amdgcn_sched_group_barrier(0x008, 1, 0); __builtin_amdgcn_sched_group_barrier(0x100, 1, 0); }
                __builtin_amdgcn_sched_group_barrier(0x008, 4, 0);
                if (need_mask) {
#pragma unroll
                    for (int i = 0; i < 16; ++i) {
                        const int krow = 32 * sub + (i & 3) + 8 * (i >> 2) + 4 * hh;
                        const bool valid = (kt == 0) ? (krow < NMETA) : (kbase + krow <= qs);
                        s[i] = valid ? s[i] : -1e30f;
                    }
                }
                float mt = s[0];
#pragma unroll
                for (int i = 1; i < 16; ++i) mt = fmaxf(mt, s[i]);
                mt = max_x32(mt);
                const float mnew = fmaxf(mrun, mt);
                const float alpha = __builtin_amdgcn_exp2f(mrun - mnew);
                mrun = mnew;
                float ps = 0.f;
#pragma unroll
                for (int i = 0; i < 16; ++i) { s[i] = __builtin_amdgcn_exp2f(s[i] - mnew); ps += s[i]; }
                lrun = lrun * alpha + ps;
                if (__builtin_amdgcn_ballot_w64(alpha != 1.0f) != 0ull) {
#pragma unroll
                    for (int d = 0; d < 4; ++d)
#pragma unroll
                        for (int i = 0; i < 16; ++i) o[d][i] *= alpha;
                }
                bf16x8 pb[2];
#pragma unroll
                for (int s2 = 0; s2 < 2; ++s2) {
                    u32x4 w;
                    w.x = cvt_pk_bf16(s[8 * s2 + 0], s[8 * s2 + 1]); w.y = cvt_pk_bf16(s[8 * s2 + 2], s[8 * s2 + 3]);
                    w.z = cvt_pk_bf16(s[8 * s2 + 4], s[8 * s2 + 5]); w.w = cvt_pk_bf16(s[8 * s2 + 6], s[8 * s2 + 7]);
                    pb[s2] = __builtin_bit_cast(bf16x8, w);
                }
#pragma unroll
                for (int d = 0; d < 4; ++d)
#pragma unroll
                    for (int s2 = 0; s2 < 2; ++s2) {
                        const LAS unsigned char* a = vb + voff + (32 * sub + 16 * s2) * VROW + d * 64;
                        const s16x4 lo = tr16(a), hi = tr16(a + 8 * VROW);
                        const bf16x8 vf = __builtin_shufflevector(lo, hi, 0, 1, 2, 3, 4, 5, 6, 7);
                        o[d] = __builtin_amdgcn_mfma_f32_32x32x16_bf16(vf, pb[s2], o[d], 0, 0, 0);
                    }
                __builtin_amdgcn_sched_group_barrier(0x100, 4, 0);
#pragma unroll
                for (int i = 0; i < 6; ++i) { __builtin_amdgcn_sched_group_barrier(0x008, 1, 0); __builtin_amdgcn_sched_group_barrier(0x100, 2, 0); }
                __builtin_amdgcn_sched_group_barrier(0x008, 2, 0);
                __builtin_amdgcn_sched_barrier(0);
            }
        }
        if (kt + 1 < ntile) attn_store_tile(R, lds + (cur ^ 1) * KBUF, lds + 2 * KBUF + (cur ^ 1) * VBUF);
        __syncthreads();
    }
    const float ltot = sum_x32(lrun);
    const float inv = 1.0f / ltot;
    f32x16 o2[4];
#pragma unroll
    for (int d = 0; d < 4; ++d)
#pragma unroll
        for (int i = 0; i < 16; ++i) o2[d][i] = 0.f;
    const LAS unsigned char* WVL = lds + WVT_LDS + r * WVROW + 16 * hh;
    const bf16_t* P = (const bf16_t*)(p.ws + WS_P) + qrow * N1 + C_ZA + h * 128 + 8 * hh;
    asm volatile("" : "+v"(P));
    u32x4 zq[8];
#pragma unroll
    for (int i = 0; i < 8; ++i) zq[i] = *(const u32x4*)(P + 32 * (i >> 1) + 16 * (i & 1));
#pragma unroll
    for (int d = 0; d < 4; ++d)
#pragma unroll
        for (int s2 = 0; s2 < 2; ++s2) {
            u32x4 w;
            w.x = cvt_pk_bf16(o[d][8 * s2 + 0] * inv, o[d][8 * s2 + 1] * inv); w.y = cvt_pk_bf16(o[d][8 * s2 + 2] * inv, o[d][8 * s2 + 3] * inv);
            w.z = cvt_pk_bf16(o[d][8 * s2 + 4] * inv, o[d][8 * s2 + 5] * inv); w.w = cvt_pk_bf16(o[d][8 * s2 + 6] * inv, o[d][8 * s2 + 7] * inv);
            const bf16x8 pb = __builtin_bit_cast(bf16x8, w);
            const int c0 = 32 * d + 16 * s2;
#pragma unroll
            for (int dvt = 0; dvt < 4; ++dvt) {
                const bf16x8 af = *(const LAS bf16x8*)(WVL + dvt * 32 * WVROW + c0 * 2);
                o2[dvt] = __builtin_amdgcn_mfma_f32_32x32x16_bf16(af, pb, o2[dvt], 0, 0, 0);
            }
            asm volatile("" ::: "memory");
        }
    float ss = 0.f;
#pragma unroll
    for (int d = 0; d < 4; ++d)
#pragma unroll
        for (int i = 0; i < 16; ++i) ss += o2[d][i] * o2[d][i];
    ss = sum_x32(ss);
    const float rs = rsqrtf(ss * (1.0f / 128.0f) + EPS);
    bf16_t* MIX = (bf16_t*)(p.ws + WS_MIX) + qrow * DM + h * 128 + 8 * hh;
    asm volatile("" : "+v"(MIX));
#pragma unroll
    for (int d = 0; d < 4; ++d)
#pragma unroll
        for (int gp = 0; gp < 2; ++gp) {
            u32x2 za, zb, wa, wb;
            za.x = zq[2 * d + gp].x; za.y = zq[2 * d + gp].y; zb.x = zq[2 * d + gp].z; zb.y = zq[2 * d + gp].w;
            swap_x32(za, zb);
            const int g = 2 * gp;
            wa.x = cvt_pk_bf16(o2[d][4 * g + 0] * rs * silu(bf_lo(za.x)), o2[d][4 * g + 1] * rs * silu(bf_hi(za.x)));
            wa.y = cvt_pk_bf16(o2[d][4 * g + 2] * rs * silu(bf_lo(za.y)), o2[d][4 * g + 3] * rs * silu(bf_hi(za.y)));
            wb.x = cvt_pk_bf16(o2[d][4 * g + 4] * rs * silu(bf_lo(zb.x)), o2[d][4 * g + 5] * rs * silu(bf_hi(zb.x)));
            wb.y = cvt_pk_bf16(o2[d][4 * g + 6] * rs * silu(bf_lo(zb.y)), o2[d][4 * g + 7] * rs * silu(bf_hi(zb.y)));
            swap_x32(wa, wb);
            u32x4 w; w.x = wa.x; w.y = wa.y; w.z = wb.x; w.w = wb.y;
            *(u32x4*)(MIX + 32 * d + 16 * gp) = w;
        }
}

DI void load8(const bf16_t* src, float (&f)[8]) {
    const u32x4 u = *(const u32x4*)src;
    f[0] = bf_lo(u.x); f[1] = bf_hi(u.x); f[2] = bf_lo(u.y); f[3] = bf_hi(u.y); f[4] = bf_lo(u.z); f[5] = bf_hi(u.z); f[6] = bf_lo(u.w); f[7] = bf_hi(u.w);
}
DI void load_bchz(const bf16_t* pr, float (&b)[8], float (&ch)[8], float (&z)[8]) {
    const u32x4 bc0 = *(const u32x4*)(pr), hz0 = *(const u32x4*)(pr + 128), bc1 = *(const u32x4*)(pr + 8), hz1 = *(const u32x4*)(pr + 136);
    b[0] = bf_lo(bc0.x); b[1] = bf_hi(bc0.x); b[2] = bf_lo(bc0.y); b[3] = bf_hi(bc0.y); b[4] = bf_lo(bc1.x); b[5] = bf_hi(bc1.x); b[6] = bf_lo(bc1.y); b[7] = bf_hi(bc1.y);
    ch[0] = bf_lo(bc0.z) * bf_lo(hz0.x); ch[1] = bf_hi(bc0.z) * bf_hi(hz0.x); ch[2] = bf_lo(bc0.w) * bf_lo(hz0.y); ch[3] = bf_hi(bc0.w) * bf_hi(hz0.y);
    ch[4] = bf_lo(bc1.z) * bf_lo(hz1.x); ch[5] = bf_hi(bc1.z) * bf_hi(hz1.x); ch[6] = bf_lo(bc1.w) * bf_lo(hz1.y); ch[7] = bf_hi(bc1.w) * bf_hi(hz1.y);
    z[0] = bf_lo(hz0.z); z[1] = bf_hi(hz0.z); z[2] = bf_lo(hz0.w); z[3] = bf_hi(hz0.w); z[4] = bf_lo(hz1.z); z[5] = bf_hi(hz1.z); z[6] = bf_lo(hz1.w); z[7] = bf_hi(hz1.w);
}
DI void conv_fix(const Params& p, int run  ) {
    const int lane = threadIdx.x & 63, c0 = lane * 8;
    const int colb = C_CONV + (lane >> 3) * 256 + ((lane & 7) >> 1) * 32 + (lane & 1) * 16;
    const bf16_t* P = (const bf16_t*)(p.ws + WS_P) + colb; const bf16_t* PM = (const bf16_t*)(p.ws + WS_PMETA) + colb;
    bf16_t* MIX = (bf16_t*)(p.ws + WS_MIX);
    float w0[8], w1[8], w2[8];
#pragma unroll
    for (int j = 0; j < 8; ++j) { w0[j] = p.conv_w[c0 + j]; w1[j] = p.conv_w[512 + c0 + j]; w2[j] = p.conv_w[1024 + c0 + j]; }
    const int R0 = run * 64;
    const bool first = (R0 & (SEQ - 1)) == 0;
    float bq[8], zq[8], ch2[8], ch1[8];
    load_bchz(first ? PM + 14 * N1 : P + (size_t)(R0 - 2) * N1, bq, ch2, zq);
    load_bchz(first ? PM + 15 * N1 : P + (size_t)(R0 - 1) * N1, bq, ch1, zq);
#pragma unroll
    for (int i = 0; i < 2; ++i) {
        float b[8], ch0[8], z[8], y[8];
        load_bchz(P + (size_t)(R0 + i) * N1, b, ch0, z);
        float ss = 0.f;
#pragma unroll
        for (int j = 0; j < 8; ++j) { y[j] = b[j] * (w0[j] * ch2[j] + w1[j] * ch1[j] + w2[j] * ch0[j]); ss += y[j] * y[j]; ch2[j] = ch1[j]; ch1[j] = ch0[j]; }
        ss += __shfl_xor(ss, 1); ss += __shfl_xor(ss, 2); ss += __shfl_xor(ss, 4);
        const float rs = rsqrtf(ss * (1.0f / 64.0f) + EPS);
#pragma unroll
        for (int j = 0; j < 8; ++j) y[j] = y[j] * rs * silu(z[j]);
        u32x4 w; w.x = cvt_pk_bf16(y[0], y[1]); w.y = cvt_pk_bf16(y[2], y[3]); w.z = cvt_pk_bf16(y[4], y[5]); w.w = cvt_pk_bf16(y[6], y[7]);
        *(u32x4*)(MIX + (size_t)(R0 + i) * DM + 512 + c0) = w;
    }
}

__global__ void __launch_bounds__(512) fwd_megakernel(Params p) {
    extern __shared__ __attribute__((aligned(16))) unsigned char shm[];
    LAS unsigned char* lds = (LAS unsigned char*)shm;
    cg::grid_group grid = cg::this_grid();
    const int nb = gridDim.x, bid = blockIdx.x;
#define PH_ON(n) (p.ph_lo <= (n) && (n) < p.ph_hi)
#define PH_SYNC(n) if (p.ph_lo < (n) && (n) < p.ph_hi) xcd_barrier(xb)
    volatile LAS unsigned* xst = (volatile LAS unsigned*)(lds + 131072);
    if (threadIdx.x < 4) xst[threadIdx.x] = 0u;
    __syncthreads();
    const XcdBarrier xb = xcd_barrier_post((unsigned*)(p.ws + WS_BAR), xst);
    if (p.ph_hi > 1000) grid.sync();
    {
        if (PH_ON(0)) {
            for (int rep = 0; rep < REP0; ++rep) phase0(p);
        }
        PH_SYNC(1);
        for (int rep = 0; rep < REPSYNC; ++rep) xcd_barrier(xb);
        if (PH_ON(1)) {
            pg8::Gemm g; g.A = (const bf16_t*)(p.ws + WS_XB); g.Bt = (const bf16_t*)(p.ws + WS_W1T); g.lda = DM; g.ldb = DM; g.K = DM; g.nM = NTOK / 256; g.nN = N1 / 256; g.aoff_pn = 1 << 30; g.aoff_bytes = 0;
            pg8::StaticOrder S; S.init(g.nM, g.nN, nb, bid);
            meta_inproj(p);
            Epi1 E; E.P = (bf16_t*)(p.ws + WS_P); E.KPE = (bf16_t*)(p.ws + WS_KPE); E.rstd = (const float*)(p.ws + WS_RSTDH); E.ssq_q = (float*)(p.ws + WS_SSQQ); E.ssq_kv = (float*)(p.ws + WS_SSQKV); E.cs = (const float*)(p.ws + WS_CS);
            E.MIX = (bf16_t*)(p.ws + WS_MIX); E.conv_w = p.conv_w; E.part = (LAS float*)(lds + 131072 + 64);
            E.acc_on = true; pg8::gemm_phase<Epi1>(lds, g, S, E);
#if REP1 > 1
            __syncthreads(); E.acc_on = false; pg8::gemm_phase<Epi1>(lds, g, S, E);
#endif
        }
        PH_SYNC(3);
        if (PH_ON(3)) for (int rep = 0; rep < REP3; ++rep) {
            if (bid < 256) {
                const int it = bid, xcd = it & 7, slot = it >> 3;
                const int b = 2 * xcd + (slot >> 4), h = (slot >> 2) & 3, jp = slot & 3;
                {
                    u32x4 wreg[12];
                    q_stage_load(p, h, wreg);
                    for (int run = bid + nb * (threadIdx.x >> 6); run < NTOK / 64; run += nb * 8) conv_fix(p, run);
                    q_stage_store(lds, wreg);
                }
                __syncthreads();
                q_block(p, lds, b, h, 7 - jp);
                q_block(p, lds, b, h, jp);
                __syncthreads();
                {
                    const bf16_t* WVT = (const bf16_t*)(p.ws + WS_WVT) + (size_t)h * 128 * 128;
#pragma unroll
                    for (int i = 0; i < 4; ++i) { const int id = threadIdx.x + 512 * i, row = id >> 4, cc = id & 15; *(LAS u32x4*)(lds + WVT_LDS + row * WVROW + cc * 16) = *(const u32x4*)(WVT + row * 128 + cc * 8); }
                }
                attn_block(p, lds, b, h, 7 - jp);
                attn_block(p, lds, b, h, jp);
            }

        }
        PH_SYNC(4);
        if (PH_ON(4)) {
            pg8::Gemm g; g.A = (const bf16_t*)(p.ws + WS_MIX); g.Bt = (const bf16_t*)(p.ws + WS_W3T); g.lda = DM; g.ldb = DM; g.K = DM; g.nM = NTOK / 256; g.nN = DM / 256; g.aoff_pn = 1 << 30; g.aoff_bytes = 0;
            pg8::StaticOrder S; S.init(g.nM, g.nN, nb, bid);
            Epi3 E; E.O = p.out; E.X = p.x; E.ssq = (float*)(p.ws + WS_SSQO); E.fg = p.final_g; E.cnt = (unsigned*)(p.ws + WS_BAR + 16384); E.fused = (nb == 256); E.part = (LAS float*)(lds + 131072 + 64);
            pg8::gemm_phase<Epi3>(lds, g, S, E);
        }
        if (nb != 256) { PH_SYNC(5); }
        if (PH_ON(5) && nb != 256) for (int rep = REP5 - 1; rep >= 0; --rep) {
            const float* ssq = (const float*)(p.ws + WS_SSQO);
            const int wid = threadIdx.x >> 6, lane = threadIdx.x & 63;
            f32x4 g4[4];
#pragma unroll
            for (int i = 0; i < 4; ++i) g4[i] = *(const f32x4*)(p.final_g + lane * 4 + 256 * i);
            for (int row = bid * 8 + wid; row < NTOK; row += nb * 8) {
                const float rs = rsqrtf(ssq[row] * (1.0f / DM) + EPS);
                float* orow = p.out + (size_t)row * DM;
                float* drow = rep ? (float*)(p.ws + WS_P) + (size_t)row * DM : orow;
#pragma unroll
                for (int i = 0; i < 4; ++i) { f32x4 v = *(const f32x4*)(orow + lane * 4 + 256 * i); v = v * rs * g4[i]; *(f32x4*)(drow + lane * 4 + 256 * i) = v; }
            }
        }
    }
}

extern "C" void kernel_launch(void* const* d_in, const int* in_sizes, int n_in, void* d_out, int out_size, void* d_ws, size_t ws_size, hipStream_t stream) {
    constexpr int LDS = 131072 + 64 + 4096;
    static int grid_blocks = 0;
    if (!grid_blocks) {
        int dev = 0, cus = 0, per_cu = 0;
        hipGetDevice(&dev);
        hipDeviceGetAttribute(&cus, hipDeviceAttributeMultiprocessorCount, dev);
        if (hipFuncSetAttribute((const void*)fwd_megakernel, hipFuncAttributeMaxDynamicSharedMemorySize, LDS) != hipSuccess) fprintf(stderr, "hipFuncSetAttribute failed\n");
        hipOccupancyMaxActiveBlocksPerMultiprocessor(&per_cu, (const void*)fwd_megakernel, 512, LDS);
        if (per_cu < 1) fprintf(stderr, "occupancy query says %d blocks per CU\n", per_cu);
        grid_blocks = cus;
        if (cus != 256) fprintf(stderr, "this kernel is laid out for a 256-CU device (got %d)\n", cus);
        if (ws_size < WS_END) fprintf(stderr, "workspace too small: %zu < %zu\n", ws_size, (size_t)WS_END);
    }
    Params p{};
    p.x = (const float*)d_in[0]; p.meta = (const float*)d_in[1]; p.norm_g = (const float*)d_in[2]; p.w_in = (const float*)d_in[3];
    p.q_norm_g = (const float*)d_in[4]; p.w_q_up = (const float*)d_in[5]; p.kv_norm_g = (const float*)d_in[6]; p.w_kv_up = (const float*)d_in[7];
    p.conv_w = (const float*)d_in[8]; p.attn_out_g = (const float*)d_in[9]; p.conv_out_g = (const float*)d_in[10]; p.w_out = (const float*)d_in[11];
    p.final_g = (const float*)d_in[12];
    p.out = (float*)d_out; p.ws = (unsigned char*)d_ws;
    for (int i = 0; i < 32; ++i) p.inv_freq[i] = 1.0f / powf(10000.0f, (float)i / 32.0f);
    p.ph_lo = 0; p.ph_hi = 6;
    if (hipMemsetAsync((char*)d_ws + WS_BAR, 0, 65536, stream) != hipSuccess) fprintf(stderr, "memset of the barrier words failed\n");
    void* args[] = {&p};
    hipError_t e = hipLaunchCooperativeKernel((void*)fwd_megakernel, dim3(grid_blocks), dim3(512), args, LDS, stream);
    if (e != hipSuccess) fprintf(stderr, "cooperative launch failed: %s (grid %d)\n", hipGetErrorString(e), grid_blocks);
}
```

```cpp
#include <hip/hip_runtime.h>
#include <hip/hip_cooperative_groups.h>
#include <cstdio>
#include <cmath>
namespace cg = cooperative_groups;

#define LAS __attribute__((address_space(3)))
#define DI __device__ __forceinline__
typedef unsigned short bf16_t;
typedef short bf16x8 __attribute__((ext_vector_type(8)));
typedef short s16x4 __attribute__((ext_vector_type(4)));
typedef float f32x4 __attribute__((ext_vector_type(4)));
typedef float f32x2 __attribute__((ext_vector_type(2)));
typedef float f32x16 __attribute__((ext_vector_type(16)));
typedef unsigned u32x4 __attribute__((ext_vector_type(4)));
typedef unsigned u32x2 __attribute__((ext_vector_type(2)));

#define REP0 1
#define REP1 1
#define REP2 1
#define REP3 1
#define REP4 1
#define REP5 1
#define REPSYNC 0
constexpr int NTOK = 32768;
constexpr int SEQ = 2048;
constexpr int DM = 1024;
constexpr int NMETA = 16;
constexpr int NIN = 3008;
constexpr int N1 = 3072;
constexpr int N2 = 768;
constexpr int K2 = 256;
constexpr float EPS = 1e-6f;
constexpr float QSCALE = 0.07216878364870322f * 1.4426950408889634f;
constexpr int C_CKV = 256, C_KR = 384, C_ZA = 448, C_PAD = 960, C_CONV = 1024;

constexpr size_t WS_XB = 0;
constexpr size_t WS_MIX = WS_XB + (size_t)NTOK * DM * 2;
constexpr size_t WS_P = WS_MIX + (size_t)NTOK * DM * 2;
constexpr size_t WS_Q = WS_P + (size_t)NTOK * N1 * 2;
constexpr size_t WS_NKV = WS_Q + (size_t)NTOK * 768 * 2;
constexpr size_t WS_KPE = WS_NKV + (size_t)NTOK * 128 * 2;
constexpr size_t WS_W1T = WS_KPE + (size_t)NTOK * 64 * 2;
constexpr size_t WS_W2T = WS_W1T + (size_t)N1 * DM * 2;
constexpr size_t WS_W3T = WS_W2T + (size_t)N2 * K2 * 2;
constexpr size_t WS_PMETA = WS_W3T + (size_t)DM * DM * 2;
constexpr size_t WS_NKVM = WS_PMETA + (size_t)16 * N1 * 2;
constexpr size_t WS_KPEMETA = WS_NKVM + (size_t)16 * 128 * 2;
constexpr size_t WS_CS = WS_KPEMETA + (size_t)16 * 64 * 2;
constexpr size_t WS_RSTDH = WS_CS + (size_t)2064 * 32 * 8;
constexpr size_t WS_SSQQ = WS_RSTDH + (size_t)NTOK * 4;
constexpr size_t WS_SSQKV = WS_SSQQ + (size_t)NTOK * 4;
constexpr size_t WS_SSQO = WS_SSQKV + (size_t)NTOK * 4;
constexpr size_t WS_WVT = WS_SSQO + (size_t)NTOK * 4;
constexpr size_t WS_MG = WS_WVT + (size_t)512 * 128 * 2;
constexpr size_t WS_RSTDM = WS_MG + (size_t)16 * DM * 2;
constexpr size_t WS_BAR = WS_RSTDM + 256;
constexpr size_t WS_END = WS_BAR + 65536;

struct Params {
    const float* x; const float* meta; const float* norm_g; const float* w_in; const float* q_norm_g; const float* w_q_up;
    const float* kv_norm_g; const float* w_kv_up; const float* conv_w; const float* attn_out_g; const float* conv_out_g;
    const float* w_out; const float* final_g;
    float* out; unsigned char* ws;
    float inv_freq[32];
    int ph_lo, ph_hi;
};

DI unsigned cvt_pk_bf16(float lo, float hi) { unsigned r; asm volatile("v_cvt_pk_bf16_f32 %0, %1, %2" : "=v"(r) : "v"(lo), "v"(hi)); return r; }
DI float bf_lo(unsigned u) { return __uint_as_float(u << 16); }
DI float bf_hi(unsigned u) { return __uint_as_float(u & 0xffff0000u); }
DI float bf2f(bf16_t b) { return __uint_as_float(((unsigned)b) << 16); }
DI bf16_t f2bf(float f) { unsigned u = __float_as_uint(f); u += 0x7FFFu + ((u >> 16) & 1u); return (bf16_t)(u >> 16); }
DI float silu(float z) { return z * __builtin_amdgcn_rcpf(1.0f + __builtin_amdgcn_exp2f(-1.4426950408889634f * z)); }
DI float max_x32(float x) { const u32x2 r = __builtin_amdgcn_permlane32_swap(__float_as_uint(x), __float_as_uint(x), false, false); return fmaxf(__uint_as_float(r.x), __uint_as_float(r.y)); }
DI float sum_x32(float x) { const u32x2 r = __builtin_amdgcn_permlane32_swap(__float_as_uint(x), __float_as_uint(x), false, false); return __uint_as_float(r.x) + __uint_as_float(r.y); }
DI void swap_x32(u32x2& a, u32x2& b) {
    const u32x2 rx = __builtin_amdgcn_permlane32_swap(a.x, b.x, false, false), ry = __builtin_amdgcn_permlane32_swap(a.y, b.y, false, false);
    a.x = rx.x; b.x = rx.y; a.y = ry.x; b.y = ry.y;
}
DI float wave_sum(float v) {
#pragma unroll
    for (int o = 32; o >= 1; o >>= 1) v += __shfl_xor(v, o);
    return v;
}
DI int colmap1(int n) {
    if (n < C_KR) return n;
    if (n < C_ZA) { const int j = n - C_KR; return C_KR + (j >> 1) + 32 * (j & 1); }
    if (n < C_PAD) return n;
    if (n < C_CONV) return -1;
    const int u = n - C_CONV, g = u >> 8, cl = u & 255;
    const int t = ((cl >> 7) << 1) | ((cl >> 2) & 1), ch = ((cl >> 5) & 3) * 16 + ((cl >> 3) & 3) * 4 + (cl & 3);
    return 960 + 512 * t + 64 * g + ch;
}
DI int colmap2q(int n) {
    const int h = n / 192, d = n - h * 192;
    if (d < 128) return n;
    const int j = d - 128; return h * 192 + 128 + (j >> 1) + 32 * (j & 1);
}


#define XB_TMO      128
#define XB_XCNT(j)  (256  + 64 * (j))
#define XB_XSUB(j)  (1280 + 64 * (j))
#define XB_XGEN(j)  (2304 + 64 * (j))
#define XB_TOP      3328
#define XB_TOPGEN   3392
#define XCD_BAR_WORDS 3456
#define XB_SPIN_CAP (1u << 18)
DI unsigned xb_ld(unsigned* p)              { return __hip_atomic_load(p, __ATOMIC_RELAXED, __HIP_MEMORY_SCOPE_AGENT); }
DI unsigned xb_add(unsigned* p, unsigned v) { return __hip_atomic_fetch_add(p, v, __ATOMIC_RELAXED, __HIP_MEMORY_SCOPE_AGENT); }
DI unsigned xb_xcc_id() { return (unsigned)__builtin_amdgcn_s_getreg((3 << 11) | 20) & 0xFu; }
#define XB_SPIN(cond, bar) do { unsigned _sp = 0; while (cond) { __builtin_amdgcn_s_sleep(1); \
    if ((++_sp & 255u) == 0u) { if (xb_ld(&(bar)[XB_TMO])) break; if (_sp > XB_SPIN_CAP) { atomicAdd(&(bar)[XB_TMO], 1u); break; } } } } while (0)
struct XcdBarrier { unsigned* bar; unsigned x; volatile LAS unsigned* st; };
DI XcdBarrier xcd_barrier_post(unsigned* bar, volatile LAS unsigned* st) {
    XcdBarrier b; b.bar = bar; b.x = xb_xcc_id(); b.st = st;
    if (threadIdx.x == 0) (void)xb_add(&bar[XB_XCNT(b.x)], 1u);
    return b;
}
DI void xcd_barrier_complete(unsigned* bar, unsigned x, unsigned& nloc, unsigned& nx) {
    const unsigned G = gridDim.x * gridDim.y * gridDim.z;
    unsigned sum, cnt, mine, sp = 0u;
    for (;;) {
        sum = 0u; cnt = 0u; mine = 0u;
#pragma unroll
        for (unsigned j = 0; j < 16; ++j) { const unsigned c = xb_ld(&bar[XB_XCNT(j)]); sum += c; cnt += (c > 0u) ? 1u : 0u; mine = (j == x) ? c : mine; }
        if (sum == G) break;
        __builtin_amdgcn_s_sleep(1);
        if ((++sp & 255u) == 0u) { if (xb_ld(&bar[XB_TMO])) break; if (sp > XB_SPIN_CAP) { atomicAdd(&bar[XB_TMO], 1u); break; } }
    }
    nloc = mine > 0u ? mine : 1u; nx = cnt > 0u ? cnt : 1u;
}
DI void xcd_barrier(const XcdBarrier& b) {
    asm volatile("s_waitcnt vmcnt(0)" ::: "memory");
    __syncthreads();
    if (threadIdx.x == 0) {
        unsigned* bar = b.bar;
        __builtin_amdgcn_s_waitcnt(0);
        unsigned nloc = b.st[0], nx = b.st[1];
        if (nloc == 0u) { xcd_barrier_complete(bar, b.x, nloc, nx); b.st[0] = nloc; b.st[1] = nx; }
        const unsigned old = xb_add(&bar[XB_XSUB(b.x)], 1u);
        const unsigned gen = old / nloc;
        if (old + 1u == (gen + 1u) * nloc) {
            __builtin_amdgcn_fence(__ATOMIC_RELEASE, "agent");
            asm volatile("s_waitcnt vmcnt(0)" ::: "memory");
            const unsigned og = xb_add(&bar[XB_TOP], 1u);
            const unsigned tg = og / nx;
            if (og + 1u == (tg + 1u) * nx) xb_add(&bar[XB_TOPGEN], 1u);
            else XB_SPIN(xb_ld(&bar[XB_TOPGEN]) == tg, bar);
            __builtin_amdgcn_fence(__ATOMIC_ACQUIRE, "agent");
            xb_add(&bar[XB_XGEN(b.x)], 1u);
            asm volatile("s_waitcnt vmcnt(0)" ::: "memory");
        } else {
            XB_SPIN(xb_ld(&bar[XB_XGEN(b.x)]) == gen, bar);
            __builtin_amdgcn_fence(__ATOMIC_ACQUIRE, "agent");
            asm volatile("s_waitcnt vmcnt(0)" ::: "memory");
        }
    }
    __syncthreads();
}

namespace pg8 {
constexpr int BM = 256, BK = 64, HALF = 128, HTB = HALF * BK * 2, STAGE_BYTES = 8 * HTB, NXCD = 8, WGM = 8;
DI int lds_byte(int r, int c) { const int st = (r >> 4) * 2 + (c >> 5), rr = r & 15, cc = c & 31, ob = rr * 64 + cc * 2; return st * 1024 + (ob ^ (((ob >> 9) & 1) << 5)); }
DI void stage_rc(int b, int& R, int& C) { const int st = b / 1024, sb = b % 1024, swz = sb ^ (((sb >> 9) & 1) << 5); R = (st >> 1) * 16 + swz / 64; C = (st & 1) * 32 + (swz % 64) / 2; }
DI int perm32(int rho) { const int n = rho >> 4, i = rho & 15; return 8 * (i >> 2) + 4 * n + (i & 3); }
struct Unit { int pm, pn; };
struct Gemm { const bf16_t* A; const bf16_t* Bt; int lda, ldb, K, nM, nN; int aoff_pn, aoff_bytes; };
struct StaticOrder {
    int nM, nN, nwg, G, c;
    DI void init(int nM_, int nN_, int G_, int c_) { nM = nM_; nN = nN_; nwg = nM * nN; G = G_; c = c_; }
    DI bool next(int i, Unit& u) const {
        const long L = (long)i * G + c; if (L >= nwg) return false;
        int wgid = (int)L; { const int q = nwg / NXCD, r = nwg % NXCD, xcd = wgid % NXCD, off = wgid / NXCD; wgid = (xcd < r ? xcd * (q + 1) : r * (q + 1) + (xcd - r) * q) + off; }
        const int nig = WGM * nN, gid = wgid / nig, fm = gid * WGM, gsz = (nM - fm) < WGM ? (nM - fm) : WGM;
        u.pm = fm + ((wgid % nig) % gsz); u.pn = (wgid % nig) / gsz; return true;
    }
};

template <class Epi>
DI void gemm_phase(LAS unsigned char* lds, const Gemm g, const StaticOrder& S, const Epi& E) {
    const int tid = threadIdx.x, wid = __builtin_amdgcn_readfirstlane(tid >> 6), lane = tid & 63, wr = wid >> 2, wc = wid & 3, fr = lane & 15, fq = lane >> 4;
    int K = g.K; asm volatile("" : "+s"(K)); const int nt = K / BK;
    unsigned voffA[2], voffB[2];
#pragma unroll
    for (int i = 0; i < 2; ++i) { int R, C; stage_rc(tid * 16 + i * 8192, R, C); const int Rb = Epi::PERM ? ((R & ~31) + perm32(R & 31)) : R;
        voffA[i] = (unsigned)(R * g.lda + C) * 2u; voffB[i] = (unsigned)(Rb * g.ldb + C) * 2u; }
    const size_t kstep = (size_t)(BK * 2);
    const size_t hstepA = (size_t)HALF * g.lda * 2, hstepB = (size_t)HALF * g.ldb * 2;
    const size_t tstepA = 2 * hstepA, tstepB = 2 * hstepB;
    const unsigned ldsw = (unsigned)wid * 1024u;
    const int aoff = lds_byte(wr * 64 + fr, fq * 8), boff = lds_byte(wc * 32 + fr, fq * 8);
#define PG8_SA(b, h) (((b) * 2 + (h)) * HTB)
#define PG8_SB(b, h) ((4 + (b) * 2 + (h)) * HTB)
#define PG8_STAGE(bufoff, gbase, voff) do { _Pragma("unroll") for (int _i = 0; _i < 2; ++_i) \
        __builtin_amdgcn_global_load_lds((const unsigned*)((const char*)(gbase) + (voff)[_i]), (LAS unsigned*)(lds + (bufoff) + ldsw + _i * 8192), 16, 0, 0); } while (0)
#define PG8_LDA(dst, b, h) do { _Pragma("unroll") for (int m = 0; m < 4; ++m) _Pragma("unroll") for (int k = 0; k < 2; ++k) dst[m][k] = *(const LAS bf16x8*)(lds + PG8_SA(b, h) + aoff + m * 2048 + k * 1024); } while (0)
#define PG8_LDB(dst, b, h) do { _Pragma("unroll") for (int n = 0; n < 2; ++n) _Pragma("unroll") for (int k = 0; k < 2; ++k) dst[n][k] = *(const LAS bf16x8*)(lds + PG8_SB(b, h) + boff + n * 2048 + k * 1024); } while (0)
#define PG8_MMA(ai, bj, At, Bt) do { __builtin_amdgcn_s_setprio(1); _Pragma("unroll") for (int m = 0; m < 4; ++m) _Pragma("unroll") for (int n = 0; n < 2; ++n) _Pragma("unroll") for (int k = 0; k < 2; ++k) \
        acc[ai][bj][m][n] = __builtin_amdgcn_mfma_f32_16x16x32_bf16(Bt[n][k], At[m][k], acc[ai][bj][m][n], 0, 0, 0); __builtin_amdgcn_s_setprio(0); } while (0)
#define PG8_WAIT_V(n) asm volatile("s_waitcnt vmcnt(" #n ")" ::: "memory")
#define PG8_WAIT_L(n) asm volatile("s_waitcnt lgkmcnt(" #n ")" ::: "memory")
#define PG8_BAR __builtin_amdgcn_s_barrier()
#define PG8_SCHED __builtin_amdgcn_sched_barrier(0)
    Unit cur, nxt; int ui = 0;
    if (!S.next(0, cur)) return;
    f32x4 acc[2][2][4][2];
#pragma unroll
    for (int a = 0; a < 2; ++a)
#pragma unroll
        for (int b = 0; b < 2; ++b)
#pragma unroll
            for (int m = 0; m < 4; ++m)
#pragma unroll
                for (int n = 0; n < 2; ++n) acc[a][b][m][n] = (f32x4){0.f, 0.f, 0.f, 0.f};
    bf16x8 At[4][2], B0[2][2], B1[2][2];
    const char* cA = (const char*)g.A + (size_t)cur.pm * tstepA + (cur.pn >= g.aoff_pn ? g.aoff_bytes : 0);
    const char* cB = (const char*)g.Bt + (size_t)cur.pn * tstepB;
    PG8_STAGE(PG8_SB(0, 0), cB, voffB); PG8_STAGE(PG8_SA(0, 0), cA, voffA); PG8_STAGE(PG8_SB(0, 1), cB + hstepB, voffB); PG8_STAGE(PG8_SA(0, 1), cA + hstepA, voffA);
    if (wr == 1) PG8_BAR;
    PG8_WAIT_V(4); PG8_BAR;
    PG8_STAGE(PG8_SB(1, 0), cB + kstep, voffB); PG8_STAGE(PG8_SA(1, 0), cA + kstep, voffA); PG8_STAGE(PG8_SB(1, 1), cB + hstepB + kstep, voffB);
    PG8_WAIT_V(6); PG8_BAR;
    for (;;) {
        const bool has_next = S.next(ui + 1, nxt);
        const char* nA = has_next ? (const char*)g.A + (size_t)nxt.pm * tstepA + (nxt.pn >= g.aoff_pn ? g.aoff_bytes : 0) : cA;
        const char* nB = has_next ? (const char*)g.Bt + (size_t)nxt.pn * tstepB : cB;
        for (int t = 0; t < nt; t += 2) {
            const bool last = (t == nt - 2);
            const char* a1 = cA + (size_t)(t + 1) * kstep; const char* b1u = cB; (void)b1u;
            const char* a2 = last ? nA : cA + (size_t)(t + 2) * kstep; const char* b2 = last ? nB : cB + (size_t)(t + 2) * kstep;
            const char* a3 = a2 + kstep; const char* b3 = b2 + kstep;
            PG8_LDB(B0, 0, 0); PG8_SCHED; PG8_LDA(At, 0, 0); PG8_STAGE(PG8_SA(1, 1), a1 + hstepA, voffA);
            PG8_WAIT_L(8); PG8_BAR; PG8_WAIT_L(0); PG8_MMA(0, 0, At, B0); PG8_BAR; PG8_SCHED;
            PG8_LDB(B1, 0, 1); PG8_STAGE(PG8_SB(0, 0), b2, voffB);
            PG8_BAR; PG8_WAIT_L(0); PG8_MMA(0, 1, At, B1); PG8_BAR;
            PG8_LDA(At, 0, 1); PG8_STAGE(PG8_SA(0, 0), a2, voffA);
            PG8_BAR; PG8_WAIT_L(0); PG8_MMA(1, 0, At, B0); PG8_BAR; PG8_SCHED;
            PG8_STAGE(PG8_SB(0, 1), b2 + hstepB, voffB);
            PG8_WAIT_V(6); PG8_BAR; PG8_MMA(1, 1, At, B1); PG8_BAR;
            PG8_LDB(B0, 1, 0); PG8_SCHED; PG8_LDA(At, 1, 0); PG8_STAGE(PG8_SA(0, 1), a2 + hstepA, voffA);
            PG8_WAIT_L(8); PG8_BAR; PG8_WAIT_L(0); PG8_MMA(0, 0, At, B0); PG8_BAR; PG8_SCHED;
            PG8_LDB(B1, 1, 1); PG8_STAGE(PG8_SB(1, 0), b3, voffB);
            PG8_BAR; PG8_WAIT_L(0); PG8_MMA(0, 1, At, B1); PG8_BAR;
            PG8_LDA(At, 1, 1); PG8_STAGE(PG8_SA(1, 0), a3, voffA);
            PG8_BAR; PG8_WAIT_L(0); PG8_MMA(1, 0, At, B0); PG8_BAR; PG8_SCHED;
            PG8_STAGE(PG8_SB(1, 1), b3 + hstepB, voffB);
            PG8_WAIT_V(6); PG8_BAR; PG8_MMA(1, 1, At, B1); PG8_BAR;
        }
        E(acc, cur, wr, wc, fr, fq);
        if (!has_next) break;
#pragma unroll
        for (int a = 0; a < 2; ++a)
#pragma unroll
            for (int b = 0; b < 2; ++b)
#pragma unroll
                for (int m = 0; m < 4; ++m)
#pragma unroll
                    for (int n = 0; n < 2; ++n) acc[a][b][m][n] = (f32x4){0.f, 0.f, 0.f, 0.f};
        cur = nxt; cA = nA; cB = nB; ++ui;
    }
    PG8_WAIT_V(0);
    if (wr == 0) PG8_BAR;
    PG8_BAR;
#undef PG8_SA
#undef PG8_SB
#undef PG8_STAGE
#undef PG8_LDA
#undef PG8_LDB
#undef PG8_MMA
#undef PG8_WAIT_V
#undef PG8_WAIT_L
#undef PG8_BAR
#undef PG8_SCHED
}
}

DI float dpp_ror1(float x) { return __builtin_bit_cast(float, __builtin_amdgcn_update_dpp(0, __builtin_bit_cast(int, x), 0x121, 0xf, 0xf, false)); }
DI float dpp_ror2(float x) { return __builtin_bit_cast(float, __builtin_amdgcn_update_dpp(0, __builtin_bit_cast(int, x), 0x122, 0xf, 0xf, false)); }
DI void rope8_load(f32x4& t0, f32x4& t1, const float* cs  , int pos, int i0) {
    t0 = *(const f32x4*)(cs + ((size_t)pos * 32 + i0) * 2);
    t1 = *(const f32x4*)(cs + ((size_t)pos * 32 + i0 + 2) * 2);
}
DI void rope8_apply(f32x4& v0, f32x4& v1, const f32x4& t0, const f32x4& t1) {
    f32x4 o0, o1;
    o0[0] = v0[0] * t0[0] - v0[1] * t0[1]; o0[1] = v0[1] * t0[0] + v0[0] * t0[1];
    o0[2] = v0[2] * t0[2] - v0[3] * t0[3]; o0[3] = v0[3] * t0[2] + v0[2] * t0[3];
    o1[0] = v1[0] * t1[0] - v1[1] * t1[1]; o1[1] = v1[1] * t1[0] + v1[0] * t1[1];
    o1[2] = v1[2] * t1[2] - v1[3] * t1[3]; o1[3] = v1[3] * t1[2] + v1[2] * t1[3];
    v0 = o0; v1 = o1;
}
DI u32x4 pack8(const f32x4& v0, const f32x4& v1) {
    u32x4 w; w.x = cvt_pk_bf16(v0[0], v0[1]); w.y = cvt_pk_bf16(v0[2], v0[3]); w.z = cvt_pk_bf16(v1[0], v1[1]); w.w = cvt_pk_bf16(v1[2], v1[3]); return w;
}
DI float sq8(const f32x4& v0, const f32x4& v1) {
    return (v0[0] * v0[0] + v0[1] * v0[1]) + (v0[2] * v0[2] + v0[3] * v0[3]) + (v1[0] * v1[0] + v1[1] * v1[1]) + (v1[2] * v1[2] + v1[3] * v1[3]);
}

struct Epi1 {
    static constexpr bool PERM = true;
    DI void conv_epi(const f32x4 (&acc)[2][2][4][2], const pg8::Unit& u, int wr, int wc, int fr, int fq, const float (&rsv)[2][4]) const {
        const int row0 = u.pm * 256 + wr * 64 + fr, col0 = u.pn * 256 + wc * 32 + 8 * fq;
        const int chb = (u.pn - 4) * 64 + 16 * wc + 4 * fq;
        const f32x4 w0 = *(const f32x4*)(conv_w + chb), w1 = *(const f32x4*)(conv_w + 512 + chb), w2 = *(const f32x4*)(conv_w + 1024 + chb);
        f32x4 yc[8], p1 = (f32x4){0.f, 0.f, 0.f, 0.f}, p2 = p1;
#pragma unroll
        for (int it = 0; it < 8; ++it) {
            const int ai = it >> 2, m = it & 3, row = row0 + ai * 128 + m * 16;
            const float rs = rsv[ai][m];
            const f32x4 b = acc[ai][0][m][0] * rs, c = acc[ai][0][m][1] * rs, h = acc[ai][1][m][0] * rs;
            const f32x4 ch0 = c * h;
            f32x4 y1, y2;
#pragma unroll
            for (int j = 0; j < 4; ++j) { y1[j] = dpp_ror1(ch0[j]); y2[j] = dpp_ror2(ch0[j]); }
            const f32x4 v1 = (fr >= 1) ? y1 : p1, v2 = (fr >= 2) ? y2 : p2;
            p1 = y1; p2 = y2;
            const f32x4 y = b * (w0 * v2 + w1 * v1 + w2 * ch0);
            yc[it] = y;
            float ss = (y[0] * y[0] + y[1] * y[1]) + (y[2] * y[2] + y[3] * y[3]);
            ss += __shfl_xor(ss, 16); ss += __shfl_xor(ss, 32);
            if (fq == 0) part[((wr * 8 + it) * 16 + fr) * 4 + wc] = ss;
            if ((m == 0 && fr < 2) || (m == 3 && fr >= 14)) {
                const f32x4 z = acc[ai][1][m][1] * rs;
                *(u32x4*)(P + (size_t)row * N1 + col0) = pack8(b, c);
                *(u32x4*)(P + (size_t)row * N1 + col0 + 128) = pack8(h, z);
            }
        }
        asm volatile("s_waitcnt lgkmcnt(0)" ::: "memory"); __builtin_amdgcn_s_barrier(); asm volatile("" ::: "memory");
#pragma unroll
        for (int it = 0; it < 8; ++it) {
            const int ai = it >> 2, m = it & 3, row = row0 + ai * 128 + m * 16;
            const f32x4 pp = *(const LAS f32x4*)(part + ((wr * 8 + it) * 16 + fr) * 4);
            const float rsg = rsqrtf(((pp[0] + pp[1]) + (pp[2] + pp[3])) * (1.0f / 64.0f) + EPS);
            const f32x4 z = acc[ai][1][m][1] * rsv[ai][m];
            u32x2 w;
            w.x = cvt_pk_bf16(yc[it][0] * rsg * silu(z[0]), yc[it][1] * rsg * silu(z[1])); w.y = cvt_pk_bf16(yc[it][2] * rsg * silu(z[2]), yc[it][3] * rsg * silu(z[3]));
            if (!(m == 0 && fr < 2)) *(u32x2*)(MIX + (size_t)row * DM + 512 + chb) = w;
        }
    }
    bf16_t* P; bf16_t* KPE; const float* rstd; float* ssq_q; float* ssq_kv; const float* cs; bool acc_on;
    bf16_t* MIX; const float* conv_w; LAS float* part;
    DI void operator()(const f32x4 (&acc)[2][2][4][2], const pg8::Unit& u, int wr, int wc, int fr, int fq) const {
        const int row0 = u.pm * 256 + wr * 64 + fr, col0 = u.pn * 256 + wc * 32 + 8 * fq;
        float rsv[2][4];
#pragma unroll
        for (int ai = 0; ai < 2; ++ai)
#pragma unroll
            for (int m = 0; m < 4; ++m) rsv[ai][m] = rstd[row0 + ai * 128 + m * 16];
        if (u.pn >= 4) { conv_epi(acc, u, wr, wc, fr, fq, rsv); return; }
        const bool do_rope = (u.pn == 1) && (wc < 2);
        f32x4 tn0 = (f32x4){0.f, 0.f, 0.f, 0.f}, tn1 = tn0;
        if (do_rope) rope8_load(tn0, tn1, cs, (row0 & (SEQ - 1)) + NMETA, 16 * wc + 4 * fq);
#pragma unroll
        for (int ai = 0; ai < 2; ++ai)
#pragma unroll
            for (int m = 0; m < 4; ++m) {
                const int row = row0 + ai * 128 + m * 16;
                const float rs = rsv[ai][m];
                const f32x4 tc0 = tn0, tc1 = tn1;
                if (do_rope && (ai * 4 + m) < 7) { const int rown = row0 + ((ai * 4 + m + 1) >> 2) * 128 + ((ai * 4 + m + 1) & 3) * 16; rope8_load(tn0, tn1, cs, (rown & (SEQ - 1)) + NMETA, 16 * wc + 4 * fq); }
                float sq[2];
#pragma unroll
                for (int bj = 0; bj < 2; ++bj) {
                    f32x4 v0 = acc[ai][bj][m][0] * rs, v1 = acc[ai][bj][m][1] * rs;
                    sq[bj] = sq8(v0, v1);
                    *(u32x4*)(P + (size_t)row * N1 + col0 + bj * 128) = pack8(v0, v1);
                    if (bj == 1 && do_rope) {
                        rope8_apply(v0, v1, tc0, tc1);
                        *(u32x4*)(KPE + (size_t)row * 64 + wc * 32 + 8 * fq) = pack8(v0, v1);
                    }
                }
                if (u.pn == 0) {
                    float s = sq[0] + sq[1]; s += __shfl_xor(s, 16); s += __shfl_xor(s, 32);
                    if (fq == 0 && acc_on) atomicAdd(ssq_q + row, s);
                } else if (u.pn == 1) {
                    float s = sq[0]; s += __shfl_xor(s, 16); s += __shfl_xor(s, 32);
                    if (fq == 0 && acc_on) atomicAdd(ssq_kv + row, s);
                }
                asm volatile("" ::: "memory");
            }
    }
};
struct Epi2 {
    static constexpr bool PERM = true;
    bf16_t* Q; const float* ssq_q; const float* cs;
    DI void operator()(const f32x4 (&acc)[2][2][4][2], const pg8::Unit& u, int wr, int wc, int fr, int fq) const {
        const int row0 = u.pm * 256 + wr * 64 + fr, col0 = u.pn * 256 + wc * 32 + 8 * fq;
        float rsv[2][4];
#pragma unroll
        for (int ai = 0; ai < 2; ++ai)
#pragma unroll
            for (int m = 0; m < 4; ++m) rsv[ai][m] = ssq_q[row0 + ai * 128 + m * 16];
        const int d00 = col0 % 192, d01 = (col0 + 128) % 192;
        const int ropebj = d00 >= 128 ? 0 : (d01 >= 128 ? 1 : -1), ri0 = ((ropebj == 0 ? d00 : d01) - 128) >> 1;
        f32x4 tn0 = (f32x4){0.f, 0.f, 0.f, 0.f}, tn1 = tn0;
        if (ropebj >= 0) rope8_load(tn0, tn1, cs, (row0 & (SEQ - 1)) + NMETA, ri0);
#pragma unroll
        for (int ai = 0; ai < 2; ++ai)
#pragma unroll
            for (int m = 0; m < 4; ++m) {
                const int row = row0 + ai * 128 + m * 16;
                const float rs = rsqrtf(rsv[ai][m] * (1.0f / 256.0f) + EPS) * QSCALE;
                const f32x4 tc0 = tn0, tc1 = tn1;
                if (ropebj >= 0 && (ai * 4 + m) < 7) { const int rown = row0 + ((ai * 4 + m + 1) >> 2) * 128 + ((ai * 4 + m + 1) & 3) * 16; rope8_load(tn0, tn1, cs, (rown & (SEQ - 1)) + NMETA, ri0); }
#pragma unroll
                for (int bj = 0; bj < 2; ++bj) {
                    const int c0 = col0 + bj * 128;
                    f32x4 v0 = acc[ai][bj][m][0] * rs, v1 = acc[ai][bj][m][1] * rs;
                    if (ropebj == bj) rope8_apply(v0, v1, tc0, tc1);
                    *(u32x4*)(Q + (size_t)row * 768 + c0) = pack8(v0, v1);
                }
                asm volatile("" ::: "memory");
            }
    }
};
struct Epi3 {
    static constexpr bool PERM = false;
    float* O; const float* X; float* ssq; const float* fg; unsigned* cnt; bool fused; LAS float* part;
    DI void operator()(f32x4 (&acc)[2][2][4][2], const pg8::Unit& u, int wr, int wc, int fr, int fq) const {
        const int row0 = u.pm * 256 + wr * 64 + fr, col0 = u.pn * 256 + wc * 32 + 4 * fq;
        f32x4 xq[3][4];
#pragma unroll
        for (int pre = 0; pre < 3; ++pre) {
            const int rowp = row0 + (pre >> 2) * 128 + (pre & 3) * 16;
#pragma unroll
            for (int q = 0; q < 4; ++q) xq[pre][q] = __builtin_nontemporal_load((const f32x4*)(X + (size_t)rowp * DM + col0 + (q >> 1) * 128 + (q & 1) * 16));
        }
#pragma unroll
        for (int it = 0; it < 8; ++it) {
            const int ai = it >> 2, m = it & 3;
            const int row = row0 + ai * 128 + m * 16;
            f32x4 xc[4];
#pragma unroll
            for (int q = 0; q < 4; ++q) xc[q] = xq[it % 3][q];
            if (it + 3 < 8) {
                const int rown = row0 + ((it + 3) >> 2) * 128 + ((it + 3) & 3) * 16;
#pragma unroll
                for (int q = 0; q < 4; ++q) xq[it % 3][q] = __builtin_nontemporal_load((const f32x4*)(X + (size_t)rown * DM + col0 + (q >> 1) * 128 + (q & 1) * 16));
            }
            float s = 0.f;
#pragma unroll
            for (int bj = 0; bj < 2; ++bj)
#pragma unroll
                for (int n = 0; n < 2; ++n) {
                    const f32x4 v = acc[ai][bj][m][n] + xc[bj * 2 + n];
                    acc[ai][bj][m][n] = v;
                    if (!fused) *(f32x4*)(O + (size_t)row * DM + col0 + bj * 128 + n * 16) = v;
                    s += (v[0] * v[0] + v[1] * v[1]) + (v[2] * v[2] + v[3] * v[3]);
                }
            s += __shfl_xor(s, 16); s += __shfl_xor(s, 32);
            if (!fused) { if (fq == 0) atomicAdd(ssq + row, s); }
            else if (fq == 0) part[((wr * 8 + it) * 16 + fr) * 4 + wc] = s;
        }
        if (!fused) return;
        asm volatile("s_waitcnt lgkmcnt(0)" ::: "memory"); __builtin_amdgcn_s_barrier(); asm volatile("" ::: "memory");
        {
            const int l5 = fr + 16 * (fq & 1), itq = 2 * wc + (l5 >> 4);
            if (fq < 2) {
                const f32x4 pp = *(const LAS f32x4*)(part + ((wr * 8 + itq) * 16 + fr) * 4);
                atomicAdd(ssq + u.pm * 256 + wr * 64 + fr + (itq >> 2) * 128 + (itq & 3) * 16, (pp[0] + pp[1]) + (pp[2] + pp[3]));
            }
        }
        asm volatile("s_waitcnt vmcnt(0)" ::: "memory");
        unsigned* c = cnt + 64 * u.pm;
        if (fr == 0 && fq == 0) (void)__hip_atomic_fetch_add(c, 1u, __ATOMIC_RELAXED, __HIP_MEMORY_SCOPE_AGENT);
        asm volatile("" ::: "memory"); __builtin_amdgcn_s_barrier(); asm volatile("" ::: "memory");
        if (wr == 0 && wc == 0) {
            unsigned sp = 0;
            while (__hip_atomic_load(c, __ATOMIC_RELAXED, __HIP_MEMORY_SCOPE_AGENT) < 32u) { __builtin_amdgcn_s_sleep(1); if (++sp > (1u << 20)) break; }
        }
        asm volatile("" ::: "memory"); __builtin_amdgcn_s_barrier(); asm volatile("" ::: "memory");
        f32x4 g4[2][2];
#pragma unroll
        for (int bj = 0; bj < 2; ++bj)
#pragma unroll
            for (int n = 0; n < 2; ++n) g4[bj][n] = *(const f32x4*)(fg + col0 + bj * 128 + n * 16);
        float sv[2][4];
#pragma unroll
        for (int ai = 0; ai < 2; ++ai)
#pragma unroll
            for (int m = 0; m < 4; ++m) sv[ai][m] = __hip_atomic_load(ssq + row0 + ai * 128 + m * 16, __ATOMIC_RELAXED, __HIP_MEMORY_SCOPE_AGENT);
#pragma unroll
        for (int ai = 0; ai < 2; ++ai)
#pragma unroll
            for (int m = 0; m < 4; ++m) {
                const int row = row0 + ai * 128 + m * 16;
                const float rs = rsqrtf(sv[ai][m] * (1.0f / DM) + EPS);
#pragma unroll
                for (int bj = 0; bj < 2; ++bj)
#pragma unroll
                    for (int n = 0; n < 2; ++n)
                        *(f32x4*)(O + (size_t)row * DM + col0 + bj * 128 + n * 16) = acc[ai][bj][m][n] * rs * g4[bj][n];
                asm volatile("" ::: "memory");
            }
    }
};

template <int MODE>
DI void transpose_wtile(const Params& p, int n0, int k0) {
    const int lane = threadIdx.x & 63, k = k0 + lane;
    float g;
    if (MODE == 1) g = p.norm_g[k];
    if (MODE == 2) g = p.q_norm_g[k];
    if (MODE == 3) g = (k < 512 ? p.attn_out_g[k] : p.conv_out_g[k - 512]);
    if (MODE == 4) g = p.kv_norm_g[k];
    float v[16];
    const bool vec4 = (MODE == 3) || (MODE == 4) || (MODE == 1 && !(n0 >= C_KR && n0 < C_ZA) && !(n0 >= C_PAD && n0 < C_CONV));
    if (vec4) {
#pragma unroll
        for (int q = 0; q < 4; ++q) {
            const int n = n0 + 4 * q;
            f32x4 w;
            if (MODE == 1) w = *(const f32x4*)(p.w_in + (size_t)k * NIN + colmap1(n));
            if (MODE == 2) w = (f32x4){0.f, 0.f, 0.f, 0.f};
            if (MODE == 3) w = *(const f32x4*)(p.w_out + (size_t)k * DM + n);
            if (MODE == 4) w = *(const f32x4*)(p.w_kv_up + (size_t)k * 1024 + (n >> 7) * 256 + 128 + (n & 127));
#pragma unroll
            for (int j = 0; j < 4; ++j) v[4 * q + j] = w[j] * g;
        }
    } else {
#pragma unroll
        for (int i = 0; i < 16; ++i) {
            const int n = n0 + i;
            float w = 0.f;
            if (MODE == 1) { const int c = colmap1(n); if (c >= 0) w = p.w_in[(size_t)k * NIN + c]; }
            if (MODE == 2) w = p.w_q_up[(size_t)k * 768 + colmap2q(n)];
            v[i] = w * g;
        }
    }
    bf16_t* dst = (bf16_t*)(p.ws + (MODE == 1 ? WS_W1T : (MODE == 2 ? WS_W2T : (MODE == 3 ? WS_W3T : WS_WVT))));
    const int ldd = (MODE == 2) ? K2 : (MODE == 4 ? 128 : DM);
    const int kd = (MODE == 4) ? ((k & ~15) | ((k & 4) << 1) | ((k & 8) >> 1) | (k & 3)) : k;
#pragma unroll
    for (int i = 0; i < 16; ++i) dst[(size_t)(n0 + i) * ldd + kd] = f2bf(v[i]);
}
DI void wqk_task(const Params& p, int u) {
    const int lane = threadIdx.x & 63, k = (u & 3) * 64 + lane, hc = u >> 2, h = hc >> 5, c0 = (hc & 31) * 4;
    float a[4] = {0.f, 0.f, 0.f, 0.f};
    const float* qrow = p.w_q_up + (size_t)k * 768 + h * 192;
    const float* kb = p.w_kv_up + (size_t)c0 * 1024 + h * 256;
#pragma unroll 1
    for (int ec = 0; ec < 4; ++ec) {
        f32x4 q[8];
#pragma unroll
        for (int i = 0; i < 8; ++i) q[i] = *(const f32x4*)(qrow + ec * 32 + 4 * i);
#pragma unroll
        for (int ci = 0; ci < 4; ++ci)
#pragma unroll
            for (int i = 0; i < 8; ++i) {
                const f32x4 w = *(const f32x4*)(kb + (size_t)ci * 1024 + ec * 32 + 4 * i);
                a[ci] += (q[i][0] * w[0] + q[i][1] * w[1]) + (q[i][2] * w[2] + q[i][3] * w[3]);
            }
    }
    const float gq = p.q_norm_g[k];
    bf16_t* dst = (bf16_t*)(p.ws + WS_W2T);
#pragma unroll
    for (int ci = 0; ci < 4; ++ci) dst[(size_t)(h * 192 + c0 + ci) * K2 + k] = f2bf(a[ci] * gq * p.kv_norm_g[c0 + ci]);
}

DI void phase0(const Params& p) {
    const int tid = threadIdx.x, wid = __builtin_amdgcn_readfirstlane(tid >> 6), lane = tid & 63, nb = gridDim.x, bid = blockIdx.x;
    const int gw = bid * 2 + wid, nw = nb * 2;
    if (wid < 2) {
    {
        float* cs = (float*)(p.ws + WS_CS);
        for (int i = gw * 64 + lane; i < 2064 * 32; i += nw * 64) {
            const int pos = i >> 5, f = i & 31;
            const float ang = (float)pos * p.inv_freq[f];
            double rev = (double)ang * 0.15915494309189535; rev -= rint(rev);
            const float r = (float)rev;
            cs[2 * i] = __builtin_amdgcn_cosf(r); cs[2 * i + 1] = __builtin_amdgcn_sinf(r);
        }
        float* z = (float*)(p.ws + WS_SSQQ);
        for (int i = gw * 64 + lane; i < 3 * NTOK; i += nw * 64) z[i] = 0.f;
    }
    for (int u = gw; u < 512; u += nw) wqk_task(p, u);
    for (int r = gw; r < NMETA; r += nw) {
        bf16_t* MG = (bf16_t*)(p.ws + WS_MG); float ss = 0.f;
#pragma unroll
        for (int i = 0; i < 4; ++i) {
            const int k = lane * 4 + 256 * i;
            const f32x4 m = *(const f32x4*)(p.meta + r * DM + k), g = *(const f32x4*)(p.norm_g + k);
            ss += (m[0] * m[0] + m[1] * m[1]) + (m[2] * m[2] + m[3] * m[3]);
            u32x2 w; w.x = cvt_pk_bf16(m[0] * g[0], m[1] * g[1]); w.y = cvt_pk_bf16(m[2] * g[2], m[3] * g[3]);
            *(u32x2*)(MG + r * DM + k) = w;
        }
        ss = wave_sum(ss);
        if (lane == 0) ((float*)(p.ws + WS_RSTDM))[r] = rsqrtf(ss * (1.0f / DM) + EPS);
    }
    {
        constexpr int T1 = (N1 / 16) * (DM / 64), T2 = 16 * (K2 / 64), T3 = (DM / 16) * (DM / 64), T4 = 32 * 2;
        for (int t = gw; t < T1 + T2 + T3 + T4; t += nw) {
            if (t < T1) transpose_wtile<1>(p, (t >> 4) * 16, (t & 15) * 64);
            else if (t < T1 + T2) { const int u = t - T1, nt = u >> 2; transpose_wtile<2>(p, (nt >> 2) * 192 + 128 + (nt & 3) * 16, (u & 3) * 64); }
            else if (t < T1 + T2 + T3) { const int u = t - T1 - T2; transpose_wtile<3>(p, (u >> 4) * 16, (u & 15) * 64); }
            else { const int u = t - T1 - T2 - T3; transpose_wtile<4>(p, (u >> 1) * 16, (u & 1) * 64); }
        }
    }
    }
    {
        bf16_t* XB = (bf16_t*)(p.ws + WS_XB); float* rstd = (float*)(p.ws + WS_RSTDH);
        for (int kk = (wid >= 2 ? wid - 2 : 30 + wid); ; kk += (wid >= 2 ? 6 : 32)) {
            if (wid >= 2 && (kk % 32) >= 30) kk += 2;
            const int row = (bid + nb * kk) * 4;
            if (row >= NTOK) break;
            const float* xr = p.x + (size_t)row * DM;
            f32x4 v[16]; float s[4] = {0.f, 0.f, 0.f, 0.f};
#pragma unroll
            for (int i = 0; i < 16; ++i) v[i] = __builtin_nontemporal_load((const f32x4*)(xr + (i >> 2) * DM + lane * 4 + 256 * (i & 3)));
#pragma unroll
            for (int i = 0; i < 16; ++i) s[i >> 2] += (v[i][0] * v[i][0] + v[i][1] * v[i][1]) + (v[i][2] * v[i][2] + v[i][3] * v[i][3]);
#pragma unroll
            for (int i = 0; i < 16; ++i) { u32x2 w; w.x = cvt_pk_bf16(v[i][0], v[i][1]); w.y = cvt_pk_bf16(v[i][2], v[i][3]); *(u32x2*)(XB + (size_t)(row + (i >> 2)) * DM + lane * 4 + 256 * (i & 3)) = w; }
#pragma unroll
            for (int r = 0; r < 4; ++r) { const float t = wave_sum(s[r]); if (lane == 0) rstd[row + r] = rsqrtf(t * (1.0f / DM) + EPS); }
        }
    }
}

DI void meta_tile(const Params& p, int n0) {
    const int lane = threadIdx.x & 63, c = lane & 15, q = lane >> 4;
    const bf16_t* MG = (const bf16_t*)(p.ws + WS_MG) + c * DM + 8 * q;
    const bf16_t* W = (const bf16_t*)(p.ws + WS_W1T) + (size_t)(n0 + c) * DM + 8 * q;
    f32x4 acc = (f32x4){0.f, 0.f, 0.f, 0.f};
#pragma unroll 8
    for (int s = 0; s < 32; ++s) {
        const bf16x8 a = *(const bf16x8*)(MG + 32 * s), b = *(const bf16x8*)(W + 32 * s);
        acc = __builtin_amdgcn_mfma_f32_16x16x32_bf16(a, b, acc, 0, 0, 0);
    }
    const float* rsm = (const float*)(p.ws + WS_RSTDM);
    bf16_t* PM = (bf16_t*)(p.ws + WS_PMETA);
#pragma unroll
    for (int r = 0; r < 4; ++r) PM[(4 * q + r) * N1 + n0 + c] = f2bf(acc[r] * rsm[4 * q + r]);
}
DI void meta_inproj(const Params& p) {
    const int wid = __builtin_amdgcn_readfirstlane(threadIdx.x >> 6), nb = gridDim.x, bid = blockIdx.x;
    for (int ti = bid; ti < 192; ti += nb) if (((ti / nb) & 7) == wid) meta_tile(p, ti * 16);
}

constexpr int KROW = 400, VROW = 320;
constexpr int KBUF = 64 * KROW, VBUF = 64 * VROW;
constexpr int WVT_LDS = 2 * KBUF + 2 * VBUF, WVROW = 272;
DI s16x4 tr16(const LAS unsigned char* a) { return __builtin_amdgcn_ds_read_tr16_b64_v4i16((LAS s16x4*)a); }

struct TileRegs { u32x4 k[3]; float ssq; };
DI void attn_load_meta(const Params& p, TileRegs& R) {
    const int t = threadIdx.x, row = t >> 3, cg = t & 7;
    const u32x4 zero = (u32x4){0u, 0u, 0u, 0u};
    R.k[0] = zero; R.k[1] = zero; R.k[2] = zero; R.ssq = 0.f;
    if (row < NMETA) {
        const bf16_t* PM = (const bf16_t*)(p.ws + WS_PMETA) + row * N1;
        const u32x4 a = *(const u32x4*)(PM + C_CKV + cg * 8), b = *(const u32x4*)(PM + C_CKV + 64 + cg * 8), c = *(const u32x4*)(PM + C_KR + cg * 8);
        float ss = bf_lo(a.x) * bf_lo(a.x) + bf_hi(a.x) * bf_hi(a.x) + bf_lo(a.y) * bf_lo(a.y) + bf_hi(a.y) * bf_hi(a.y)
                 + bf_lo(a.z) * bf_lo(a.z) + bf_hi(a.z) * bf_hi(a.z) + bf_lo(a.w) * bf_lo(a.w) + bf_hi(a.w) * bf_hi(a.w)
                 + bf_lo(b.x) * bf_lo(b.x) + bf_hi(b.x) * bf_hi(b.x) + bf_lo(b.y) * bf_lo(b.y) + bf_hi(b.y) * bf_hi(b.y)
                 + bf_lo(b.z) * bf_lo(b.z) + bf_hi(b.z) * bf_hi(b.z) + bf_lo(b.w) * bf_lo(b.w) + bf_hi(b.w) * bf_hi(b.w);
        ss += __shfl_xor(ss, 1); ss += __shfl_xor(ss, 2); ss += __shfl_xor(ss, 4);
        R.k[0] = a; R.k[1] = b; R.ssq = ss;
        f32x4 t0, t1, v0, v1;
        rope8_load(t0, t1, (const float*)(p.ws + WS_CS), row, cg * 4);
        v0[0] = bf_lo(c.x); v0[1] = bf_hi(c.x); v0[2] = bf_lo(c.y); v0[3] = bf_hi(c.y); v1[0] = bf_lo(c.z); v1[1] = bf_hi(c.z); v1[2] = bf_lo(c.w); v1[3] = bf_hi(c.w);
        rope8_apply(v0, v1, t0, t1);
        R.k[2] = pack8(v0, v1);
    }
}
DI void attn_load_tile(TileRegs& R, const bf16_t* kvp, const bf16_t* kpp, const float* sqp) {
    R.k[0] = *(const u32x4*)(kvp); R.k[1] = *(const u32x4*)(kvp + 64); R.k[2] = *(const u32x4*)(kpp); R.ssq = *sqp;
}
DI u32x4 scale8(const u32x4& u, float rs) {
    u32x4 w;
    w.x = cvt_pk_bf16(bf_lo(u.x) * rs, bf_hi(u.x) * rs); w.y = cvt_pk_bf16(bf_lo(u.y) * rs, bf_hi(u.y) * rs);
    w.z = cvt_pk_bf16(bf_lo(u.z) * rs, bf_hi(u.z) * rs); w.w = cvt_pk_bf16(bf_lo(u.w) * rs, bf_hi(u.w) * rs);
    return w;
}
DI void attn_store_tile(const TileRegs& R, LAS unsigned char* kb, LAS unsigned char* vb) {
    const int t = threadIdx.x, row = t >> 3, cg = t & 7;
    LAS unsigned char* kd = kb + row * KROW + cg * 16; LAS unsigned char* vd = vb + row * VROW + cg * 16;
    const float rs = rsqrtf(R.ssq * (1.0f / 128.0f) + EPS);
    const u32x4 n0 = scale8(R.k[0], rs), n1 = scale8(R.k[1], rs);
    *(LAS u32x4*)(kd) = n0; *(LAS u32x4*)(kd + 128) = n1; *(LAS u32x4*)(kd + 256) = R.k[2];
    *(LAS u32x4*)(vd) = n0; *(LAS u32x4*)(vd + 128) = n1;
}

constexpr int WQROW = 272, WQHALF = 192 * WQROW;
DI void q_stage(const Params& p, LAS unsigned char* lds, int h) {
    const bf16_t* W = (const bf16_t*)(p.ws + WS_W2T) + (size_t)h * 192 * K2;
#pragma unroll
    for (int i = 0; i < 12; ++i) {
        const int id = threadIdx.x + 512 * i, row = id >> 5, cc = id & 31;
        *(LAS u32x4*)(lds + (cc >> 4) * WQHALF + row * WQROW + (cc & 15) * 16) = *(const u32x4*)(W + row * K2 + cc * 8);
    }
}
DI void q_block(const Params& p, const LAS unsigned char* lds, int b, int h, int j) {
    const int tid = threadIdx.x, wid = tid >> 6, lane = tid & 63, r = lane & 31, hh = lane >> 5;
    const int qs = 256 * j + 32 * wid + r;
    const size_t qrow = (size_t)b * SEQ + qs;
    const bf16_t* cqp = (const bf16_t*)(p.ws + WS_P) + qrow * N1 + 8 * hh;
    bf16x8 cq[16];
#pragma unroll
    for (int s = 0; s < 16; ++s) cq[s] = *(const bf16x8*)(cqp + 16 * s);
    const float rsq = rsqrtf(((const float*)(p.ws + WS_SSQQ))[qrow] * (1.0f / 256.0f) + EPS) * QSCALE;
    const float* cs = (const float*)(p.ws + WS_CS) + ((size_t)(qs + NMETA) * 32 + 2 * hh) * 2;
    bf16_t* Q = (bf16_t*)(p.ws + WS_Q) + qrow * 768 + h * 192 + 8 * hh;
    const LAS unsigned char* wl = lds + r * WQROW + 16 * hh;
    f32x16 acc[6];
#pragma unroll
    for (int dt = 0; dt < 6; ++dt)
#pragma unroll
        for (int i = 0; i < 16; ++i) acc[dt][i] = 0.f;
#pragma unroll
    for (int s = 0; s < 16; ++s) {
#pragma unroll
        for (int d3 = 0; d3 < 6; d3 += 3) {
            bf16x8 af[3];
#pragma unroll
            for (int dt = 0; dt < 3; ++dt) af[dt] = *(const LAS bf16x8*)(wl + (s >> 3) * WQHALF + (d3 + dt) * 32 * WQROW + (s & 7) * 32);
#pragma unroll
            for (int dt = 0; dt < 3; ++dt) acc[d3 + dt] = __builtin_amdgcn_mfma_f32_32x32x16_bf16(af[dt], cq[s], acc[d3 + dt], 0, 0, 0);
        }
    }
    asm volatile("" : "+v"(cs));
    f32x4 tr[8];
#pragma unroll
    for (int i = 0; i < 8; ++i) tr[i] = *(const f32x4*)(cs + (16 * (i >> 2) + 4 * (i & 3)) * 2);
#pragma unroll
    for (int dt = 0; dt < 6; ++dt)
#pragma unroll
        for (int gp = 0; gp < 2; ++gp) {
            u32x2 wq[2];
#pragma unroll
            for (int e = 0; e < 2; ++e) {
                const int g = 2 * gp + e;
                float v0 = acc[dt][4 * g] * rsq, v1 = acc[dt][4 * g + 1] * rsq, v2 = acc[dt][4 * g + 2] * rsq, v3 = acc[dt][4 * g + 3] * rsq;
                if (dt >= 4) {
                    const f32x4 t = tr[(dt - 4) * 4 + g];
                    const float a0 = v0 * t[0] - v1 * t[1], a1 = v1 * t[0] + v0 * t[1], a2 = v2 * t[2] - v3 * t[3], a3 = v3 * t[2] + v2 * t[3];
                    v0 = a0; v1 = a1; v2 = a2; v3 = a3;
                }
                wq[e].x = cvt_pk_bf16(v0, v1); wq[e].y = cvt_pk_bf16(v2, v3);
            }
            swap_x32(wq[0], wq[1]);
            u32x4 w; w.x = wq[0].x; w.y = wq[0].y; w.z = wq[1].x; w.w = wq[1].y;
            *(u32x4*)(Q + 32 * dt + 16 * gp) = w;
        }
}

DI void attn_block(const Params& p, LAS unsigned char* lds, int b, int h, int j) {
    const int tid = threadIdx.x, wid = tid >> 6, lane = tid & 63, r = lane & 31, hh = lane >> 5;
    const bf16_t* QB = (const bf16_t*)(p.ws + WS_Q);
    const int qs = 256 * j + 32 * wid + r;
    const size_t qrow = (size_t)b * SEQ + qs;
    bf16x8 qf[12];
#pragma unroll
    for (int s = 0; s < 12; ++s) qf[s] = *(const bf16x8*)(QB + qrow * 768 + h * 192 + 16 * s + 8 * hh);
    f32x16 o[4];
#pragma unroll
    for (int d = 0; d < 4; ++d)
#pragma unroll
        for (int i = 0; i < 16; ++i) o[d][i] = 0.f;
    float mrun = -1e30f, lrun = 0.f;
    const int ntile = 4 * j + 5;
    const int wave_rowmax = 256 * j + 32 * wid + 31, wave_rowmin = 256 * j + 32 * wid;
    TileRegs R;
    attn_load_meta(p, R);
    attn_store_tile(R, lds, lds + 2 * KBUF);
    __syncthreads();
    const bf16_t* kvp = (const bf16_t*)(p.ws + WS_P) + ((size_t)b * SEQ + (tid >> 3)) * N1 + C_CKV + (tid & 7) * 8;
    const float* sqp = (const float*)(p.ws + WS_SSQKV) + (size_t)b * SEQ + (tid >> 3);
    const bf16_t* kpp = (const bf16_t*)(p.ws + WS_KPE) + ((size_t)b * SEQ + (tid >> 3)) * 64 + (tid & 7) * 8;
    const int koff = r * KROW + 16 * hh;
    const int voff = (4 * hh + ((lane & 15) >> 2)) * VROW + (16 * ((lane >> 4) & 1) + 4 * (lane & 3)) * 2;
    for (int kt = 0; kt < ntile; ++kt) {
        const int cur = kt & 1;
        if (kt + 1 < ntile) { attn_load_tile(R, kvp, kpp, sqp); kvp += 64 * N1; kpp += 64 * 64; sqp += 64; }
        const LAS unsigned char* kb = lds + cur * KBUF;
        const LAS unsigned char* vb = lds + 2 * KBUF + cur * VBUF;
        const int kbase = (kt - 1) * 64;
        const bool active = (kt == 0) || (kbase <= wave_rowmax);
        if (active) {
            const bool need_mask = (kt == 0) || (kbase + 63 > wave_rowmin);
#pragma unroll
            for (int sub = 0; sub < 2; ++sub) {
                f32x16 s;
#pragma unroll
                for (int i = 0; i < 16; ++i) s[i] = 0.f;
#pragma unroll
                for (int st = 0; st < 12; ++st) {
                    const bf16x8 kf = *(const LAS bf16x8*)(kb + koff + sub * 32 * KROW + st * 32);
                    s = __builtin_amdgcn_mfma_f32_32x32x16_bf16(kf, qf[st], s, 0, 0, 0);
                }
                __builtin_amdgcn_sched_group_barrier(0x100, 4, 0);
#pragma unroll
                for (int i = 0; i < 8; ++i) { __builtin_amdgcn_sched_group_barrier(0x008, 1, 0); __builtin_amdgcn_sched_group_barrier(0x100, 1, 0); }
                __builtin_amdgcn_sched_group_barrier(0x008, 4, 0);
                if (need_mask) {
#pragma unroll
                    for (int i = 0; i < 16; ++i) {
                        const int krow = 32 * sub + (i & 3) + 8 * (i >> 2) + 4 * hh;
                        const bool valid = (kt == 0) ? (krow < NMETA) : (kbase + krow <= qs);
                        s[i] = valid ? s[i] : -1e30f;
                    }
                }
                float mt = s[0];
#pragma unroll
                for (int i = 1; i < 16; ++i) mt = fmaxf(mt, s[i]);
                mt = max_x32(mt);
                if (__builtin_amdgcn_ballot_w64(mt - mrun > 8.0f) != 0ull) {
                    const float mnew = fmaxf(mrun, mt);
                    const float alpha = __builtin_amdgcn_exp2f(mrun - mnew);
                    mrun = mnew;
                    lrun *= alpha;
#pragma unroll
                    for (int d = 0; d < 4; ++d)
#pragma unroll
                        for (int i = 0; i < 16; ++i) o[d][i] *= alpha;
                }
                float ps = 0.f;
#pragma unroll
                for (int i = 0; i < 16; ++i) { s[i] = __builtin_amdgcn_exp2f(s[i] - mrun); ps += s[i]; }
                lrun += ps;
                bf16x8 pb[2];
#pragma unroll
                for (int s2 = 0; s2 < 2; ++s2) {
                    u32x4 w;
                    w.x = cvt_pk_bf16(s[8 * s2 + 0], s[8 * s2 + 1]); w.y = cvt_pk_bf16(s[8 * s2 + 2], s[8 * s2 + 3]);
                    w.z = cvt_pk_bf16(s[8 * s2 + 4], s[8 * s2 + 5]); w.w = cvt_pk_bf16(s[8 * s2 + 6], s[8 * s2 + 7]);
                    pb[s2] = __builtin_bit_cast(bf16x8, w);
                }
#pragma unroll
                for (int d = 0; d < 4; ++d)
#pragma unroll
                    for (int s2 = 0; s2 < 2; ++s2) {
                        const LAS unsigned char* a = vb + voff + (32 * sub + 16 * s2) * VROW + d * 64;
                        const s16x4 lo = tr16(a), hi = tr16(a + 8 * VROW);
                        const bf16x8 vf = __builtin_shufflevector(lo, hi, 0, 1, 2, 3, 4, 5, 6, 7);
                        o[d] = __builtin_amdgcn_mfma_f32_32x32x16_bf16(vf, pb[s2], o[d], 0, 0, 0);
                    }
                __builtin_amdgcn_sched_group_barrier(0x100, 4, 0);
#pragma unroll
                for (int i = 0; i < 6; ++i) { __builtin_amdgcn_sched_group_barrier(0x008, 1, 0); __builtin_amdgcn_sched_group_barrier(0x100, 2, 0); }
                __builtin_amdgcn_sched_group_barrier(0x008, 2, 0);
                __builtin_amdgcn_sched_barrier(0);
            }
        }
        if (kt + 1 < ntile) attn_store_tile(R, lds + (cur ^ 1) * KBUF, lds + 2 * KBUF + (cur ^ 1) * VBUF);
        __syncthreads();
    }
    const float ltot = sum_x32(lrun);
    const float inv = 1.0f / ltot;
    f32x16 o2[4];
#pragma unroll
    for (int d = 0; d < 4; ++d)
#pragma unroll
        for (int i = 0; i < 16; ++i) o2[d][i] = 0.f;
    const LAS unsigned char* WVL = lds + WVT_LDS + r * WVROW + 16 * hh;
    const bf16_t* P = (const bf16_t*)(p.ws + WS_P) + qrow * N1 + C_ZA + h * 128 + 8 * hh;
    asm volatile("" : "+v"(P));
    u32x4 zq[8];
#pragma unroll
    for (int i = 0; i < 8; ++i) zq[i] = *(const u32x4*)(P + 32 * (i >> 1) + 16 * (i & 1));
#pragma unroll
    for (int d = 0; d < 4; ++d)
#pragma unroll
        for (int s2 = 0; s2 < 2; ++s2) {
            u32x4 w;
            w.x = cvt_pk_bf16(o[d][8 * s2 + 0] * inv, o[d][8 * s2 + 1] * inv); w.y = cvt_pk_bf16(o[d][8 * s2 + 2] * inv, o[d][8 * s2 + 3] * inv);
            w.z = cvt_pk_bf16(o[d][8 * s2 + 4] * inv, o[d][8 * s2 + 5] * inv); w.w = cvt_pk_bf16(o[d][8 * s2 + 6] * inv, o[d][8 * s2 + 7] * inv);
            const bf16x8 pb = __builtin_bit_cast(bf16x8, w);
            const int c0 = 32 * d + 16 * s2;
#pragma unroll
            for (int dvt = 0; dvt < 4; ++dvt) {
                const bf16x8 af = *(const LAS bf16x8*)(WVL + dvt * 32 * WVROW + c0 * 2);
                o2[dvt] = __builtin_amdgcn_mfma_f32_32x32x16_bf16(af, pb, o2[dvt], 0, 0, 0);
            }
            asm volatile("" ::: "memory");
        }
    float ss = 0.f;
#pragma unroll
    for (int d = 0; d < 4; ++d)
#pragma unroll
        for (int i = 0; i < 16; ++i) ss += o2[d][i] * o2[d][i];
    ss = sum_x32(ss);
    const float rs = rsqrtf(ss * (1.0f / 128.0f) + EPS);
    bf16_t* MIX = (bf16_t*)(p.ws + WS_MIX) + qrow * DM + h * 128 + 8 * hh;
    asm volatile("" : "+v"(MIX));
#pragma unroll
    for (int d = 0; d < 4; ++d)
#pragma unroll
        for (int gp = 0; gp < 2; ++gp) {
            u32x2 za, zb, wa, wb;
            za.x = zq[2 * d + gp].x; za.y = zq[2 * d + gp].y; zb.x = zq[2 * d + gp].z; zb.y = zq[2 * d + gp].w;
            swap_x32(za, zb);
            const int g = 2 * gp;
            wa.x = cvt_pk_bf16(o2[d][4 * g + 0] * rs * silu(bf_lo(za.x)), o2[d][4 * g + 1] * rs * silu(bf_hi(za.x)));
            wa.y = cvt_pk_bf16(o2[d][4 * g + 2] * rs * silu(bf_lo(za.y)), o2[d][4 * g + 3] * rs * silu(bf_hi(za.y)));
            wb.x = cvt_pk_bf16(o2[d][4 * g + 4] * rs * silu(bf_lo(zb.x)), o2[d][4 * g + 5] * rs * silu(bf_hi(zb.x)));
            wb.y = cvt_pk_bf16(o2[d][4 * g + 6] * rs * silu(bf_lo(zb.y)), o2[d][4 * g + 7] * rs * silu(bf_hi(zb.y)));
            swap_x32(wa, wb);
            u32x4 w; w.x = wa.x; w.y = wa.y; w.z = wb.x; w.w = wb.y;
            *(u32x4*)(MIX + 32 * d + 16 * gp) = w;
        }
}

DI void load8(const bf16_t* src, float (&f)[8]) {
    const u32x4 u = *(const u32x4*)src;
    f[0] = bf_lo(u.x); f[1] = bf_hi(u.x); f[2] = bf_lo(u.y); f[3] = bf_hi(u.y); f[4] = bf_lo(u.z); f[5] = bf_hi(u.z); f[6] = bf_lo(u.w); f[7] = bf_hi(u.w);
}
DI void load_bchz(const bf16_t* pr, float (&b)[8], float (&ch)[8], float (&z)[8]) {
    const u32x4 bc0 = *(const u32x4*)(pr), hz0 = *(const u32x4*)(pr + 128), bc1 = *(const u32x4*)(pr + 8), hz1 = *(const u32x4*)(pr + 136);
    b[0] = bf_lo(bc0.x); b[1] = bf_hi(bc0.x); b[2] = bf_lo(bc0.y); b[3] = bf_hi(bc0.y); b[4] = bf_lo(bc1.x); b[5] = bf_hi(bc1.x); b[6] = bf_lo(bc1.y); b[7] = bf_hi(bc1.y);
    ch[0] = bf_lo(bc0.z) * bf_lo(hz0.x); ch[1] = bf_hi(bc0.z) * bf_hi(hz0.x); ch[2] = bf_lo(bc0.w) * bf_lo(hz0.y); ch[3] = bf_hi(bc0.w) * bf_hi(hz0.y);
    ch[4] = bf_lo(bc1.z) * bf_lo(hz1.x); ch[5] = bf_hi(bc1.z) * bf_hi(hz1.x); ch[6] = bf_lo(bc1.w) * bf_lo(hz1.y); ch[7] = bf_hi(bc1.w) * bf_hi(hz1.y);
    z[0] = bf_lo(hz0.z); z[1] = bf_hi(hz0.z); z[2] = bf_lo(hz0.w); z[3] = bf_hi(hz0.w); z[4] = bf_lo(hz1.z); z[5] = bf_hi(hz1.z); z[6] = bf_lo(hz1.w); z[7] = bf_hi(hz1.w);
}
DI void conv_fix(const Params& p, int run  ) {
    const int lane = threadIdx.x & 63, c0 = lane * 8;
    const int colb = C_CONV + (lane >> 3) * 256 + ((lane & 7) >> 1) * 32 + (lane & 1) * 16;
    const bf16_t* P = (const bf16_t*)(p.ws + WS_P) + colb; const bf16_t* PM = (const bf16_t*)(p.ws + WS_PMETA) + colb;
    bf16_t* MIX = (bf16_t*)(p.ws + WS_MIX);
    float w0[8], w1[8], w2[8];
#pragma unroll
    for (int j = 0; j < 8; ++j) { w0[j] = p.conv_w[c0 + j]; w1[j] = p.conv_w[512 + c0 + j]; w2[j] = p.conv_w[1024 + c0 + j]; }
    const int R0 = run * 64;
    const bool first = (R0 & (SEQ - 1)) == 0;
    float bq[8], zq[8], ch2[8], ch1[8];
    load_bchz(first ? PM + 14 * N1 : P + (size_t)(R0 - 2) * N1, bq, ch2, zq);
    load_bchz(first ? PM + 15 * N1 : P + (size_t)(R0 - 1) * N1, bq, ch1, zq);
#pragma unroll
    for (int i = 0; i < 2; ++i) {
        float b[8], ch0[8], z[8], y[8];
        load_bchz(P + (size_t)(R0 + i) * N1, b, ch0, z);
        float ss = 0.f;
#pragma unroll
        for (int j = 0; j < 8; ++j) { y[j] = b[j] * (w0[j] * ch2[j] + w1[j] * ch1[j] + w2[j] * ch0[j]); ss += y[j] * y[j]; ch2[j] = ch1[j]; ch1[j] = ch0[j]; }
        ss += __shfl_xor(ss, 1); ss += __shfl_xor(ss, 2); ss += __shfl_xor(ss, 4);
        const float rs = rsqrtf(ss * (1.0f / 64.0f) + EPS);
#pragma unroll
        for (int j = 0; j < 8; ++j) y[j] = y[j] * rs * silu(z[j]);
        u32x4 w; w.x = cvt_pk_bf16(y[0], y[1]); w.y = cvt_pk_bf16(y[2], y[3]); w.z = cvt_pk_bf16(y[4], y[5]); w.w = cvt_pk_bf16(y[6], y[7]);
        *(u32x4*)(MIX + (size_t)(R0 + i) * DM + 512 + c0) = w;
    }
}

__global__ void __launch_bounds__(512) fwd_megakernel(Params p) {
    extern __shared__ __attribute__((aligned(16))) unsigned char shm[];
    LAS unsigned char* lds = (LAS unsigned char*)shm;
    cg::grid_group grid = cg::this_grid();
    const int nb = gridDim.x, bid = blockIdx.x;
#define PH_ON(n) (p.ph_lo <= (n) && (n) < p.ph_hi)
#define PH_SYNC(n) if (p.ph_lo < (n) && (n) < p.ph_hi) xcd_barrier(xb)
    volatile LAS unsigned* xst = (volatile LAS unsigned*)(lds + 131072);
    if (threadIdx.x < 4) xst[threadIdx.x] = 0u;
    __syncthreads();
    const XcdBarrier xb = xcd_barrier_post((unsigned*)(p.ws + WS_BAR), xst);
    if (p.ph_hi > 1000) grid.sync();
    {
        if (PH_ON(0)) {
            for (int rep = 0; rep < REP0; ++rep) phase0(p);
        }
        PH_SYNC(1);
        for (int rep = 0; rep < REPSYNC; ++rep) xcd_barrier(xb);
        if (PH_ON(1)) {
            pg8::Gemm g; g.A = (const bf16_t*)(p.ws + WS_XB); g.Bt = (const bf16_t*)(p.ws + WS_W1T); g.lda = DM; g.ldb = DM; g.K = DM; g.nM = NTOK / 256; g.nN = N1 / 256; g.aoff_pn = 1 << 30; g.aoff_bytes = 0;
            pg8::StaticOrder S; S.init(g.nM, g.nN, nb, bid);
            meta_inproj(p);
            Epi1 E; E.P = (bf16_t*)(p.ws + WS_P); E.KPE = (bf16_t*)(p.ws + WS_KPE); E.rstd = (const float*)(p.ws + WS_RSTDH); E.ssq_q = (float*)(p.ws + WS_SSQQ); E.ssq_kv = (float*)(p.ws + WS_SSQKV); E.cs = (const float*)(p.ws + WS_CS);
            E.MIX = (bf16_t*)(p.ws + WS_MIX); E.conv_w = p.conv_w; E.part = (LAS float*)(lds + 131072 + 64);
            E.acc_on = true; pg8::gemm_phase<Epi1>(lds, g, S, E);
#if REP1 > 1
            __syncthreads(); E.acc_on = false; pg8::gemm_phase<Epi1>(lds, g, S, E);
#endif
        }
        PH_SYNC(3);
        if (PH_ON(3)) for (int rep = 0; rep < REP3; ++rep) {
            for (int run = bid + nb * (threadIdx.x >> 6); run < NTOK / 64; run += nb * 8) conv_fix(p, run);
            if (bid < 256) {
                const int it = bid, xcd = it & 7, slot = it >> 3;
                const int b = 2 * xcd + (slot >> 4), h = (slot >> 2) & 3, jp = slot & 3;
                q_stage(p, lds, h);
                __syncthreads();
                q_block(p, lds, b, h, 7 - jp);
                q_block(p, lds, b, h, jp);
                __syncthreads();
                {
                    const bf16_t* WVT = (const bf16_t*)(p.ws + WS_WVT) + (size_t)h * 128 * 128;
#pragma unroll
                    for (int i = 0; i < 4; ++i) { const int id = threadIdx.x + 512 * i, row = id >> 4, cc = id & 15; *(LAS u32x4*)(lds + WVT_LDS + row * WVROW + cc * 16) = *(const u32x4*)(WVT + row * 128 + cc * 8); }
                }
                attn_block(p, lds, b, h, 7 - jp);
                attn_block(p, lds, b, h, jp);
            }

        }
        PH_SYNC(4);
        if (PH_ON(4)) {
            pg8::Gemm g; g.A = (const bf16_t*)(p.ws + WS_MIX); g.Bt = (const bf16_t*)(p.ws + WS_W3T); g.lda = DM; g.ldb = DM; g.K = DM; g.nM = NTOK / 256; g.nN = DM / 256; g.aoff_pn = 1 << 30; g.aoff_bytes = 0;
            pg8::StaticOrder S; S.init(g.nM, g.nN, nb, bid);
            Epi3 E; E.O = p.out; E.X = p.x; E.ssq = (float*)(p.ws + WS_SSQO); E.fg = p.final_g; E.cnt = (unsigned*)(p.ws + WS_BAR + 16384); E.fused = (nb == 256); E.part = (LAS float*)(lds + 131072 + 64);
            pg8::gemm_phase<Epi3>(lds, g, S, E);
        }
        if (nb != 256) { PH_SYNC(5); }
        if (PH_ON(5) && nb != 256) for (int rep = REP5 - 1; rep >= 0; --rep) {
            const float* ssq = (const float*)(p.ws + WS_SSQO);
            const int wid = threadIdx.x >> 6, lane = threadIdx.x & 63;
            f32x4 g4[4];
#pragma unroll
            for (int i = 0; i < 4; ++i) g4[i] = *(const f32x4*)(p.final_g + lane * 4 + 256 * i);
            for (int row = bid * 8 + wid; row < NTOK; row += nb * 8) {
                const float rs = rsqrtf(ssq[row] * (1.0f / DM) + EPS);
                float* orow = p.out + (size_t)row * DM;
                float* drow = rep ? (float*)(p.ws + WS_P) + (size_t)row * DM : orow;
#pragma unroll
                for (int i = 0; i < 4; ++i) { f32x4 v = *(const f32x4*)(orow + lane * 4 + 256 * i); v = v * rs * g4[i]; *(f32x4*)(drow + lane * 4 + 256 * i) = v; }
            }
        }
    }
}

extern "C" void kernel_launch(void* const* d_in, const int* in_sizes, int n_in, void* d_out, int out_size, void* d_ws, size_t ws_size, hipStream_t stream) {
    constexpr int LDS = 131072 + 64 + 4096;
    static int grid_blocks = 0;
    if (!grid_blocks) {
        int dev = 0, cus = 0, per_cu = 0;
        hipGetDevice(&dev);
        hipDeviceGetAttribute(&cus, hipDeviceAttributeMultiprocessorCount, dev);
        if (hipFuncSetAttribute((const void*)fwd_megakernel, hipFuncAttributeMaxDynamicSharedMemorySize, LDS) != hipSuccess) fprintf(stderr, "hipFuncSetAttribute failed\n");
        hipOccupancyMaxActiveBlocksPerMultiprocessor(&per_cu, (const void*)fwd_megakernel, 512, LDS);
        if (per_cu < 1) fprintf(stderr, "occupancy query says %d blocks per CU\n", per_cu);
        grid_blocks = cus;
        if (cus != 256) fprintf(stderr, "this kernel is laid out for a 256-CU device (got %d)\n", cus);
        if (ws_size < WS_END) fprintf(stderr, "workspace too small: %zu < %zu\n", ws_size, (size_t)WS_END);
    }
    Params p{};
    p.x = (const float*)d_in[0]; p.meta = (const float*)d_in[1]; p.norm_g = (const float*)d_in[2]; p.w_in = (const float*)d_in[3];
    p.q_norm_g = (const float*)d_in[4]; p.w_q_up = (const float*)d_in[5]; p.kv_norm_g = (const float*)d_in[6]; p.w_kv_up = (const float*)d_in[7];
    p.conv_w = (const float*)d_in[8]; p.attn_out_g = (const float*)d_in[9]; p.conv_out_g = (const float*)d_in[10]; p.w_out = (const float*)d_in[11];
    p.final_g = (const float*)d_in[12];
    p.out = (float*)d_out; p.ws = (unsigned char*)d_ws;
    for (int i = 0; i < 32; ++i) p.inv_freq[i] = 1.0f / powf(10000.0f, (float)i / 32.0f);
    p.ph_lo = 0; p.ph_hi = 6;
    if (hipMemsetAsync((char*)d_ws + WS_BAR, 0, 65536, stream) != hipSuccess) fprintf(stderr, "memset of the barrier words failed\n");
    void* args[] = {&p};
    hipError_t e = hipLaunchCooperativeKernel((void*)fwd_megakernel, dim3(grid_blocks), dim3(512), args, LDS, stream);
    if (e != hipSuccess) fprintf(stderr, "cooperative launch failed: %s (grid %d)\n", hipGetErrorString(e), grid_blocks);
}
```

```cpp
#include <hip/hip_runtime.h>
#include <hip/hip_cooperative_groups.h>
#include <cstdio>
#include <cmath>
namespace cg = cooperative_groups;

#define LAS __attribute__((address_space(3)))
#define DI __device__ __forceinline__
typedef unsigned short bf16_t;
typedef short bf16x8 __attribute__((ext_vector_type(8)));
typedef short s16x4 __attribute__((ext_vector_type(4)));
typedef float f32x4 __attribute__((ext_vector_type(4)));
typedef float f32x2 __attribute__((ext_vector_type(2)));
typedef float f32x16 __attribute__((ext_vector_type(16)));
typedef unsigned u32x4 __attribute__((ext_vector_type(4)));
typedef unsigned u32x2 __attribute__((ext_vector_type(2)));

#define REP0 1
#define REP1 1
#define REP2 1
#define REP3 1
#define REP4 1
#define REP5 1
#define REPSYNC 0
constexpr int NTOK = 32768;
constexpr int SEQ = 2048;
constexpr int DM = 1024;
constexpr int NMETA = 16;
constexpr int NIN = 3008;
constexpr int N1 = 3072;
constexpr int N2 = 768;
constexpr int K2 = 256;
constexpr float EPS = 1e-6f;
constexpr float QSCALE = 0.07216878364870322f * 1.4426950408889634f;
constexpr int C_CKV = 256, C_KR = 384, C_ZA = 448, C_PAD = 960, C_CONV = 1024;

constexpr size_t WS_XB = 0;
constexpr size_t WS_MIX = WS_XB + (size_t)NTOK * DM * 2;
constexpr size_t WS_P = WS_MIX + (size_t)NTOK * DM * 2;
constexpr size_t WS_Q = WS_P + (size_t)NTOK * N1 * 2;
constexpr size_t WS_NKV = WS_Q + (size_t)NTOK * 768 * 2;
constexpr size_t WS_KPE = WS_NKV + (size_t)NTOK * 128 * 2;
constexpr size_t WS_W1T = WS_KPE + (size_t)NTOK * 64 * 2;
constexpr size_t WS_W2T = WS_W1T + (size_t)N1 * DM * 2;
constexpr size_t WS_W3T = WS_W2T + (size_t)N2 * K2 * 2;
constexpr size_t WS_PMETA = WS_W3T + (size_t)DM * DM * 2;
constexpr size_t WS_NKVM = WS_PMETA + (size_t)16 * N1 * 2;
constexpr size_t WS_KPEMETA = WS_NKVM + (size_t)16 * 128 * 2;
constexpr size_t WS_CS = WS_KPEMETA + (size_t)16 * 64 * 2;
constexpr size_t WS_RSTDH = WS_CS + (size_t)2064 * 32 * 8;
constexpr size_t WS_SSQQ = WS_RSTDH + (size_t)NTOK * 4;
constexpr size_t WS_SSQKV = WS_SSQQ + (size_t)NTOK * 4;
constexpr size_t WS_SSQO = WS_SSQKV + (size_t)NTOK * 4;
constexpr size_t WS_WVT = WS_SSQO + (size_t)NTOK * 4;
constexpr size_t WS_MG = WS_WVT + (size_t)512 * 128 * 2;
constexpr size_t WS_RSTDM = WS_MG + (size_t)16 * DM * 2;
constexpr size_t WS_BAR = WS_RSTDM + 256;
constexpr size_t WS_END = WS_BAR + 65536;

struct Params {
    const float* x; const float* meta; const float* norm_g; const float* w_in; const float* q_norm_g; const float* w_q_up;
    const float* kv_norm_g; const float* w_kv_up; const float* conv_w; const float* attn_out_g; const float* conv_out_g;
    const float* w_out; const float* final_g;
    float* out; unsigned char* ws;
    float inv_freq[32];
    int ph_lo, ph_hi;
};

DI unsigned cvt_pk_bf16(float lo, float hi) { unsigned r; asm volatile("v_cvt_pk_bf16_f32 %0, %1, %2" : "=v"(r) : "v"(lo), "v"(hi)); return r; }
DI float bf_lo(unsigned u) { return __uint_as_float(u << 16); }
DI float bf_hi(unsigned u) { return __uint_as_float(u & 0xffff0000u); }
DI float bf2f(bf16_t b) { return __uint_as_float(((unsigned)b) << 16); }
DI bf16_t f2bf(float f) { unsigned u = __float_as_uint(f); u += 0x7FFFu + ((u >> 16) & 1u); return (bf16_t)(u >> 16); }
DI float silu(float z) { return z * __builtin_amdgcn_rcpf(1.0f + __builtin_amdgcn_exp2f(-1.4426950408889634f * z)); }
DI float max_x32(float x) { const u32x2 r = __builtin_amdgcn_permlane32_swap(__float_as_uint(x), __float_as_uint(x), false, false); return fmaxf(__uint_as_float(r.x), __uint_as_float(r.y)); }
DI float sum_x32(float x) { const u32x2 r = __builtin_amdgcn_permlane32_swap(__float_as_uint(x), __float_as_uint(x), false, false); return __uint_as_float(r.x) + __uint_as_float(r.y); }
DI void swap_x32(u32x2& a, u32x2& b) {
    const u32x2 rx = __builtin_amdgcn_permlane32_swap(a.x, b.x, false, false), ry = __builtin_amdgcn_permlane32_swap(a.y, b.y, false, false);
    a.x = rx.x; b.x = rx.y; a.y = ry.x; b.y = ry.y;
}
DI float wave_sum(float v) {
#pragma unroll
    for (int o = 32; o >= 1; o >>= 1) v += __shfl_xor(v, o);
    return v;
}
DI int colmap1(int n) {
    if (n < C_KR) return n;
    if (n < C_ZA) { const int j = n - C_KR; return C_KR + (j >> 1) + 32 * (j & 1); }
    if (n < C_PAD) return n;
    if (n < C_CONV) return -1;
    const int u = n - C_CONV, g = u >> 8, cl = u & 255;
    const int t = ((cl >> 7) << 1) | ((cl >> 2) & 1), ch = ((cl >> 5) & 3) * 16 + ((cl >> 3) & 3) * 4 + (cl & 3);
    return 960 + 512 * t + 64 * g + ch;
}
DI int colmap2q(int n) {
    const int h = n / 192, d = n - h * 192;
    if (d < 128) return n;
    const int j = d - 128; return h * 192 + 128 + (j >> 1) + 32 * (j & 1);
}


#define XB_TMO      128
#define XB_XCNT(j)  (256  + 64 * (j))
#define XB_XSUB(j)  (1280 + 64 * (j))
#define XB_XGEN(j)  (2304 + 64 * (j))
#define XB_TOP      3328
#define XB_TOPGEN   3392
#define XCD_BAR_WORDS 3456
#define XB_SPIN_CAP (1u << 18)
DI unsigned xb_ld(unsigned* p)              { return __hip_atomic_load(p, __ATOMIC_RELAXED, __HIP_MEMORY_SCOPE_AGENT); }
DI unsigned xb_add(unsigned* p, unsigned v) { return __hip_atomic_fetch_add(p, v, __ATOMIC_RELAXED, __HIP_MEMORY_SCOPE_AGENT); }
DI unsigned xb_xcc_id() { return (unsigned)__builtin_amdgcn_s_getreg((3 << 11) | 20) & 0xFu; }
#define XB_SPIN(cond, bar) do { unsigned _sp = 0; while (cond) { __builtin_amdgcn_s_sleep(1); \
    if ((++_sp & 255u) == 0u) { if (xb_ld(&(bar)[XB_TMO])) break; if (_sp > XB_SPIN_CAP) { atomicAdd(&(bar)[XB_TMO], 1u); break; } } } } while (0)
struct XcdBarrier { unsigned* bar; unsigned x; volatile LAS unsigned* st; };
DI XcdBarrier xcd_barrier_post(unsigned* bar, volatile LAS unsigned* st) {
    XcdBarrier b; b.bar = bar; b.x = xb_xcc_id(); b.st = st;
    if (threadIdx.x == 0) (void)xb_add(&bar[XB_XCNT(b.x)], 1u);
    return b;
}
DI void xcd_barrier_complete(unsigned* bar, unsigned x, unsigned& nloc, unsigned& nx) {
    const unsigned G = gridDim.x * gridDim.y * gridDim.z;
    unsigned sum, cnt, mine, sp = 0u;
    for (;;) {
        sum = 0u; cnt = 0u; mine = 0u;
#pragma unroll
        for (unsigned j = 0; j < 16; ++j) { const unsigned c = xb_ld(&bar[XB_XCNT(j)]); sum += c; cnt += (c > 0u) ? 1u : 0u; mine = (j == x) ? c : mine; }
        if (sum == G) break;
        __builtin_amdgcn_s_sleep(1);
        if ((++sp & 255u) == 0u) { if (xb_ld(&bar[XB_TMO])) break; if (sp > XB_SPIN_CAP) { atomicAdd(&bar[XB_TMO], 1u); break; } }
    }
    nloc = mine > 0u ? mine : 1u; nx = cnt > 0u ? cnt : 1u;
}
DI void xcd_barrier(const XcdBarrier& b) {
    asm volatile("s_waitcnt vmcnt(0)" ::: "memory");
    __syncthreads();
    if (threadIdx.x == 0) {
        unsigned* bar = b.bar;
        __builtin_amdgcn_s_waitcnt(0);
        unsigned nloc = b.st[0], nx = b.st[1];
        if (nloc == 0u) { xcd_barrier_complete(bar, b.x, nloc, nx); b.st[0] = nloc; b.st[1] = nx; }
        const unsigned old = xb_add(&bar[XB_XSUB(b.x)], 1u);
        const unsigned gen = old / nloc;
        if (old + 1u == (gen + 1u) * nloc) {
            __builtin_amdgcn_fence(__ATOMIC_RELEASE, "agent");
            asm volatile("s_waitcnt vmcnt(0)" ::: "memory");
            const unsigned og = xb_add(&bar[XB_TOP], 1u);
            const unsigned tg = og / nx;
            if (og + 1u == (tg + 1u) * nx) xb_add(&bar[XB_TOPGEN], 1u);
            else XB_SPIN(xb_ld(&bar[XB_TOPGEN]) == tg, bar);
            __builtin_amdgcn_fence(__ATOMIC_ACQUIRE, "agent");
            xb_add(&bar[XB_XGEN(b.x)], 1u);
            asm volatile("s_waitcnt vmcnt(0)" ::: "memory");
        } else {
            XB_SPIN(xb_ld(&bar[XB_XGEN(b.x)]) == gen, bar);
            __builtin_amdgcn_fence(__ATOMIC_ACQUIRE, "agent");
            asm volatile("s_waitcnt vmcnt(0)" ::: "memory");
        }
    }
    __syncthreads();
}

namespace pg8 {
constexpr int BM = 256, BK = 64, HALF = 128, HTB = HALF * BK * 2, STAGE_BYTES = 8 * HTB, NXCD = 8, WGM = 8;
DI int lds_byte(int r, int c) { const int st = (r >> 4) * 2 + (c >> 5), rr = r & 15, cc = c & 31, ob = rr * 64 + cc * 2; return st * 1024 + (ob ^ (((ob >> 9) & 1) << 5)); }
DI void stage_rc(int b, int& R, int& C) { const int st = b / 1024, sb = b % 1024, swz = sb ^ (((sb >> 9) & 1) << 5); R = (st >> 1) * 16 + swz / 64; C = (st & 1) * 32 + (swz % 64) / 2; }
DI int perm32(int rho) { const int n = rho >> 4, i = rho & 15; return 8 * (i >> 2) + 4 * n + (i & 3); }
struct Unit { int pm, pn; };
struct Gemm { const bf16_t* A; const bf16_t* Bt; int lda, ldb, K, nM, nN; int aoff_pn, aoff_bytes; };
struct StaticOrder {
    int nM, nN, nwg, G, c;
    DI void init(int nM_, int nN_, int G_, int c_) { nM = nM_; nN = nN_; nwg = nM * nN; G = G_; c = c_; }
    DI bool next(int i, Unit& u) const {
        const long L = (long)i * G + c; if (L >= nwg) return false;
        int wgid = (int)L; { const int q = nwg / NXCD, r = nwg % NXCD, xcd = wgid % NXCD, off = wgid / NXCD; wgid = (xcd < r ? xcd * (q + 1) : r * (q + 1) + (xcd - r) * q) + off; }
        const int nig = WGM * nN, gid = wgid / nig, fm = gid * WGM, gsz = (nM - fm) < WGM ? (nM - fm) : WGM;
        u.pm = fm + ((wgid % nig) % gsz); u.pn = (wgid % nig) / gsz; return true;
    }
};

template <class Epi>
DI void gemm_phase(LAS unsigned char* lds, const Gemm g, const StaticOrder& S, const Epi& E) {
    const int tid = threadIdx.x, wid = __builtin_amdgcn_readfirstlane(tid >> 6), lane = tid & 63, wr = wid >> 2, wc = wid & 3, fr = lane & 15, fq = lane >> 4;
    int K = g.K; asm volatile("" : "+s"(K)); const int nt = K / BK;
    unsigned voffA[2], voffB[2];
#pragma unroll
    for (int i = 0; i < 2; ++i) { int R, C; stage_rc(tid * 16 + i * 8192, R, C); const int Rb = Epi::PERM ? ((R & ~31) + perm32(R & 31)) : R;
        voffA[i] = (unsigned)(R * g.lda + C) * 2u; voffB[i] = (unsigned)(Rb * g.ldb + C) * 2u; }
    const size_t kstep = (size_t)(BK * 2);
    const size_t hstepA = (size_t)HALF * g.lda * 2, hstepB = (size_t)HALF * g.ldb * 2;
    const size_t tstepA = 2 * hstepA, tstepB = 2 * hstepB;
    const unsigned ldsw = (unsigned)wid * 1024u;
    const int aoff = lds_byte(wr * 64 + fr, fq * 8), boff = lds_byte(wc * 32 + fr, fq * 8);
#define PG8_SA(b, h) (((b) * 2 + (h)) * HTB)
#define PG8_SB(b, h) ((4 + (b) * 2 + (h)) * HTB)
#define PG8_STAGE(bufoff, gbase, voff) do { _Pragma("unroll") for (int _i = 0; _i < 2; ++_i) \
        __builtin_amdgcn_global_load_lds((const unsigned*)((const char*)(gbase) + (voff)[_i]), (LAS unsigned*)(lds + (bufoff) + ldsw + _i * 8192), 16, 0, 0); } while (0)
#define PG8_LDA(dst, b, h) do { _Pragma("unroll") for (int m = 0; m < 4; ++m) _Pragma("unroll") for (int k = 0; k < 2; ++k) dst[m][k] = *(const LAS bf16x8*)(lds + PG8_SA(b, h) + aoff + m * 2048 + k * 1024); } while (0)
#define PG8_LDB(dst, b, h) do { _Pragma("unroll") for (int n = 0; n < 2; ++n) _Pragma("unroll") for (int k = 0; k < 2; ++k) dst[n][k] = *(const LAS bf16x8*)(lds + PG8_SB(b, h) + boff + n * 2048 + k * 1024); } while (0)
#define PG8_MMA(ai, bj, At, Bt) do { __builtin_amdgcn_s_setprio(1); _Pragma("unroll") for (int m = 0; m < 4; ++m) _Pragma("unroll") for (int n = 0; n < 2; ++n) _Pragma("unroll") for (int k = 0; k < 2; ++k) \
        acc[ai][bj][m][n] = __builtin_amdgcn_mfma_f32_16x16x32_bf16(Bt[n][k], At[m][k], acc[ai][bj][m][n], 0, 0, 0); __builtin_amdgcn_s_setprio(0); } while (0)
#define PG8_WAIT_V(n) asm volatile("s_waitcnt vmcnt(" #n ")" ::: "memory")
#define PG8_WAIT_L(n) asm volatile("s_waitcnt lgkmcnt(" #n ")" ::: "memory")
#define PG8_BAR __builtin_amdgcn_s_barrier()
#define PG8_SCHED __builtin_amdgcn_sched_barrier(0)
    Unit cur, nxt; int ui = 0;
    if (!S.next(0, cur)) return;
    f32x4 acc[2][2][4][2];
#pragma unroll
    for (int a = 0; a < 2; ++a)
#pragma unroll
        for (int b = 0; b < 2; ++b)
#pragma unroll
            for (int m = 0; m < 4; ++m)
#pragma unroll
                for (int n = 0; n < 2; ++n) acc[a][b][m][n] = (f32x4){0.f, 0.f, 0.f, 0.f};
    bf16x8 At[4][2], B0[2][2], B1[2][2];
    const char* cA = (const char*)g.A + (size_t)cur.pm * tstepA + (cur.pn >= g.aoff_pn ? g.aoff_bytes : 0);
    const char* cB = (const char*)g.Bt + (size_t)cur.pn * tstepB;
    PG8_STAGE(PG8_SB(0, 0), cB, voffB); PG8_STAGE(PG8_SA(0, 0), cA, voffA); PG8_STAGE(PG8_SB(0, 1), cB + hstepB, voffB); PG8_STAGE(PG8_SA(0, 1), cA + hstepA, voffA);
    if (wr == 1) PG8_BAR;
    PG8_WAIT_V(4); PG8_BAR;
    PG8_STAGE(PG8_SB(1, 0), cB + kstep, voffB); PG8_STAGE(PG8_SA(1, 0), cA + kstep, voffA); PG8_STAGE(PG8_SB(1, 1), cB + hstepB + kstep, voffB);
    PG8_WAIT_V(6); PG8_BAR;
    for (;;) {
        const bool has_next = S.next(ui + 1, nxt);
        const char* nA = has_next ? (const char*)g.A + (size_t)nxt.pm * tstepA + (nxt.pn >= g.aoff_pn ? g.aoff_bytes : 0) : cA;
        const char* nB = has_next ? (const char*)g.Bt + (size_t)nxt.pn * tstepB : cB;
        for (int t = 0; t < nt; t += 2) {
            const bool last = (t == nt - 2);
            const char* a1 = cA + (size_t)(t + 1) * kstep; const char* b1u = cB; (void)b1u;
            const char* a2 = last ? nA : cA + (size_t)(t + 2) * kstep; const char* b2 = last ? nB : cB + (size_t)(t + 2) * kstep;
            const char* a3 = a2 + kstep; const char* b3 = b2 + kstep;
            PG8_LDB(B0, 0, 0); PG8_SCHED; PG8_LDA(At, 0, 0); PG8_STAGE(PG8_SA(1, 1), a1 + hstepA, voffA);
            PG8_WAIT_L(8); PG8_BAR; PG8_WAIT_L(0); PG8_MMA(0, 0, At, B0); PG8_BAR; PG8_SCHED;
            PG8_LDB(B1, 0, 1); PG8_STAGE(PG8_SB(0, 0), b2, voffB);
            PG8_BAR; PG8_WAIT_L(0); PG8_MMA(0, 1, At, B1); PG8_BAR;
            PG8_LDA(At, 0, 1); PG8_STAGE(PG8_SA(0, 0), a2, voffA);
            PG8_BAR; PG8_WAIT_L(0); PG8_MMA(1, 0, At, B0); PG8_BAR; PG8_SCHED;
            PG8_STAGE(PG8_SB(0, 1), b2 + hstepB, voffB);
            PG8_WAIT_V(6); PG8_BAR; PG8_MMA(1, 1, At, B1); PG8_BAR;
            PG8_LDB(B0, 1, 0); PG8_SCHED; PG8_LDA(At, 1, 0); PG8_STAGE(PG8_SA(0, 1), a2 + hstepA, voffA);
            PG8_WAIT_L(8); PG8_BAR; PG8_WAIT_L(0); PG8_MMA(0, 0, At, B0); PG8_BAR; PG8_SCHED;
            PG8_LDB(B1, 1, 1); PG8_STAGE(PG8_SB(1, 0), b3, voffB);
            PG8_BAR; PG8_WAIT_L(0); PG8_MMA(0, 1, At, B1); PG8_BAR;
            PG8_LDA(At, 1, 1); PG8_STAGE(PG8_SA(1, 0), a3, voffA);
            PG8_BAR; PG8_WAIT_L(0); PG8_MMA(1, 0, At, B0); PG8_BAR; PG8_SCHED;
            PG8_STAGE(PG8_SB(1, 1), b3 + hstepB, voffB);
            PG8_WAIT_V(6); PG8_BAR; PG8_MMA(1, 1, At, B1); PG8_BAR;
        }
        E(acc, cur, wr, wc, fr, fq);
        if (!has_next) break;
#pragma unroll
        for (int a = 0; a < 2; ++a)
#pragma unroll
            for (int b = 0; b < 2; ++b)
#pragma unroll
                for (int m = 0; m < 4; ++m)
#pragma unroll
                    for (int n = 0; n < 2; ++n) acc[a][b][m][n] = (f32x4){0.f, 0.f, 0.f, 0.f};
        cur = nxt; cA = nA; cB = nB; ++ui;
    }
    PG8_WAIT_V(0);
    if (wr == 0) PG8_BAR;
    PG8_BAR;
#undef PG8_SA
#undef PG8_SB
#undef PG8_STAGE
#undef PG8_LDA
#undef PG8_LDB
#undef PG8_MMA
#undef PG8_WAIT_V
#undef PG8_WAIT_L
#undef PG8_BAR
#undef PG8_SCHED
}
}

DI float dpp_ror1(float x) { return __builtin_bit_cast(float, __builtin_amdgcn_update_dpp(0, __builtin_bit_cast(int, x), 0x121, 0xf, 0xf, false)); }
DI float dpp_ror2(float x) { return __builtin_bit_cast(float, __builtin_amdgcn_update_dpp(0, __builtin_bit_cast(int, x), 0x122, 0xf, 0xf, false)); }
DI void rope8_load(f32x4& t0, f32x4& t1, const float* cs  , int pos, int i0) {
    t0 = *(const f32x4*)(cs + ((size_t)pos * 32 + i0) * 2);
    t1 = *(const f32x4*)(cs + ((size_t)pos * 32 + i0 + 2) * 2);
}
DI void rope8_apply(f32x4& v0, f32x4& v1, const f32x4& t0, const f32x4& t1) {
    f32x4 o0, o1;
    o0[0] = v0[0] * t0[0] - v0[1] * t0[1]; o0[1] = v0[1] * t0[0] + v0[0] * t0[1];
    o0[2] = v0[2] * t0[2] - v0[3] * t0[3]; o0[3] = v0[3] * t0[2] + v0[2] * t0[3];
    o1[0] = v1[0] * t1[0] - v1[1] * t1[1]; o1[1] = v1[1] * t1[0] + v1[0] * t1[1];
    o1[2] = v1[2] * t1[2] - v1[3] * t1[3]; o1[3] = v1[3] * t1[2] + v1[2] * t1[3];
    v0 = o0; v1 = o1;
}
DI u32x4 pack8(const f32x4& v0, const f32x4& v1) {
    u32x4 w; w.x = cvt_pk_bf16(v0[0], v0[1]); w.y = cvt_pk_bf16(v0[2], v0[3]); w.z = cvt_pk_bf16(v1[0], v1[1]); w.w = cvt_pk_bf16(v1[2], v1[3]); return w;
}
DI float sq8(const f32x4& v0, const f32x4& v1) {
    return (v0[0] * v0[0] + v0[1] * v0[1]) + (v0[2] * v0[2] + v0[3] * v0[3]) + (v1[0] * v1[0] + v1[1] * v1[1]) + (v1[2] * v1[2] + v1[3] * v1[3]);
}

struct Epi1 {
    static constexpr bool PERM = true;
    DI void conv_epi(const f32x4 (&acc)[2][2][4][2], const pg8::Unit& u, int wr, int wc, int fr, int fq, const float (&rsv)[2][4]) const {
        const int row0 = u.pm * 256 + wr * 64 + fr, col0 = u.pn * 256 + wc * 32 + 8 * fq;
        const int chb = (u.pn - 4) * 64 + 16 * wc + 4 * fq;
        const f32x4 w0 = *(const f32x4*)(conv_w + chb), w1 = *(const f32x4*)(conv_w + 512 + chb), w2 = *(const f32x4*)(conv_w + 1024 + chb);
        f32x4 yc[8], p1 = (f32x4){0.f, 0.f, 0.f, 0.f}, p2 = p1;
#pragma unroll
        for (int it = 0; it < 8; ++it) {
            const int ai = it >> 2, m = it & 3, row = row0 + ai * 128 + m * 16;
            const float rs = rsv[ai][m];
            const f32x4 b = acc[ai][0][m][0] * rs, c = acc[ai][0][m][1] * rs, h = acc[ai][1][m][0] * rs;
            const f32x4 ch0 = c * h;
            f32x4 y1, y2;
#pragma unroll
            for (int j = 0; j < 4; ++j) { y1[j] = dpp_ror1(ch0[j]); y2[j] = dpp_ror2(ch0[j]); }
            const f32x4 v1 = (fr >= 1) ? y1 : p1, v2 = (fr >= 2) ? y2 : p2;
            p1 = y1; p2 = y2;
            const f32x4 y = b * (w0 * v2 + w1 * v1 + w2 * ch0);
            yc[it] = y;
            float ss = (y[0] * y[0] + y[1] * y[1]) + (y[2] * y[2] + y[3] * y[3]);
            ss += __shfl_xor(ss, 16); ss += __shfl_xor(ss, 32);
            if (fq == 0) part[((wr * 8 + it) * 16 + fr) * 4 + wc] = ss;
            if ((m == 0 && fr < 2) || (m == 3 && fr >= 14)) {
                const f32x4 z = acc[ai][1][m][1] * rs;
                *(u32x4*)(P + (size_t)row * N1 + col0) = pack8(b, c);
                *(u32x4*)(P + (size_t)row * N1 + col0 + 128) = pack8(h, z);
            }
        }
        asm volatile("s_waitcnt lgkmcnt(0)" ::: "memory"); __builtin_amdgcn_s_barrier(); asm volatile("" ::: "memory");
#pragma unroll
        for (int it = 0; it < 8; ++it) {
            const int ai = it >> 2, m = it & 3, row = row0 + ai * 128 + m * 16;
            const f32x4 pp = *(const LAS f32x4*)(part + ((wr * 8 + it) * 16 + fr) * 4);
            const float rsg = rsqrtf(((pp[0] + pp[1]) + (pp[2] + pp[3])) * (1.0f / 64.0f) + EPS);
            const f32x4 z = acc[ai][1][m][1] * rsv[ai][m];
            u32x2 w;
            w.x = cvt_pk_bf16(yc[it][0] * rsg * silu(z[0]), yc[it][1] * rsg * silu(z[1])); w.y = cvt_pk_bf16(yc[it][2] * rsg * silu(z[2]), yc[it][3] * rsg * silu(z[3]));
            if (!(m == 0 && fr < 2)) *(u32x2*)(MIX + (size_t)row * DM + 512 + chb) = w;
        }
    }
    bf16_t* P; bf16_t* KPE; const float* rstd; float* ssq_q; float* ssq_kv; const float* cs; bool acc_on;
    bf16_t* MIX; const float* conv_w; LAS float* part;
    DI void operator()(const f32x4 (&acc)[2][2][4][2], const pg8::Unit& u, int wr, int wc, int fr, int fq) const {
        const int row0 = u.pm * 256 + wr * 64 + fr, col0 = u.pn * 256 + wc * 32 + 8 * fq;
        float rsv[2][4];
#pragma unroll
        for (int ai = 0; ai < 2; ++ai)
#pragma unroll
            for (int m = 0; m < 4; ++m) rsv[ai][m] = rstd[row0 + ai * 128 + m * 16];
        if (u.pn >= 4) { conv_epi(acc, u, wr, wc, fr, fq, rsv); return; }
        const bool do_rope = (u.pn == 1) && (wc < 2);
        f32x4 tn0 = (f32x4){0.f, 0.f, 0.f, 0.f}, tn1 = tn0;
        if (do_rope) rope8_load(tn0, tn1, cs, (row0 & (SEQ - 1)) + NMETA, 16 * wc + 4 * fq);
#pragma unroll
        for (int ai = 0; ai < 2; ++ai)
#pragma unroll
            for (int m = 0; m < 4; ++m) {
                const int row = row0 + ai * 128 + m * 16;
                const float rs = rsv[ai][m];
                const f32x4 tc0 = tn0, tc1 = tn1;
                if (do_rope && (ai * 4 + m) < 7) { const int rown = row0 + ((ai * 4 + m + 1) >> 2) * 128 + ((ai * 4 + m + 1) & 3) * 16; rope8_load(tn0, tn1, cs, (rown & (SEQ - 1)) + NMETA, 16 * wc + 4 * fq); }
                float sq[2];
#pragma unroll
                for (int bj = 0; bj < 2; ++bj) {
                    f32x4 v0 = acc[ai][bj][m][0] * rs, v1 = acc[ai][bj][m][1] * rs;
                    sq[bj] = sq8(v0, v1);
                    *(u32x4*)(P + (size_t)row * N1 + col0 + bj * 128) = pack8(v0, v1);
                    if (bj == 1 && do_rope) {
                        rope8_apply(v0, v1, tc0, tc1);
                        *(u32x4*)(KPE + (size_t)row * 64 + wc * 32 + 8 * fq) = pack8(v0, v1);
                    }
                }
                if (u.pn == 0) {
                    float s = sq[0] + sq[1]; s += __shfl_xor(s, 16); s += __shfl_xor(s, 32);
                    if (fq == 0 && acc_on) atomicAdd(ssq_q + row, s);
                } else if (u.pn == 1) {
                    float s = sq[0]; s += __shfl_xor(s, 16); s += __shfl_xor(s, 32);
                    if (fq == 0 && acc_on) atomicAdd(ssq_kv + row, s);
                }
                asm volatile("" ::: "memory");
            }
    }
};
struct Epi2 {
    static constexpr bool PERM = true;
    bf16_t* Q; const float* ssq_q; const float* cs;
    DI void operator()(const f32x4 (&acc)[2][2][4][2], const pg8::Unit& u, int wr, int wc, int fr, int fq) const {
        const int row0 = u.pm * 256 + wr * 64 + fr, col0 = u.pn * 256 + wc * 32 + 8 * fq;
        float rsv[2][4];
#pragma unroll
        for (int ai = 0; ai < 2; ++ai)
#pragma unroll
            for (int m = 0; m < 4; ++m) rsv[ai][m] = ssq_q[row0 + ai * 128 + m * 16];
        const int d00 = col0 % 192, d01 = (col0 + 128) % 192;
        const int ropebj = d00 >= 128 ? 0 : (d01 >= 128 ? 1 : -1), ri0 = ((ropebj == 0 ? d00 : d01) - 128) >> 1;
        f32x4 tn0 = (f32x4){0.f, 0.f, 0.f, 0.f}, tn1 = tn0;
        if (ropebj >= 0) rope8_load(tn0, tn1, cs, (row0 & (SEQ - 1)) + NMETA, ri0);
#pragma unroll
        for (int ai = 0; ai < 2; ++ai)
#pragma unroll
            for (int m = 0; m < 4; ++m) {
                const int row = row0 + ai * 128 + m * 16;
                const float rs = rsqrtf(rsv[ai][m] * (1.0f / 256.0f) + EPS) * QSCALE;
                const f32x4 tc0 = tn0, tc1 = tn1;
                if (ropebj >= 0 && (ai * 4 + m) < 7) { const int rown = row0 + ((ai * 4 + m + 1) >> 2) * 128 + ((ai * 4 + m + 1) & 3) * 16; rope8_load(tn0, tn1, cs, (rown & (SEQ - 1)) + NMETA, ri0); }
#pragma unroll
                for (int bj = 0; bj < 2; ++bj) {
                    const int c0 = col0 + bj * 128;
                    f32x4 v0 = acc[ai][bj][m][0] * rs, v1 = acc[ai][bj][m][1] * rs;
                    if (ropebj == bj) rope8_apply(v0, v1, tc0, tc1);
                    *(u32x4*)(Q + (size_t)row * 768 + c0) = pack8(v0, v1);
                }
                asm volatile("" ::: "memory");
            }
    }
};
struct Epi3 {
    static constexpr bool PERM = false;
    float* O; const float* X; float* ssq; const float* fg; unsigned* cnt; bool fused; LAS float* part;
    DI void operator()(f32x4 (&acc)[2][2][4][2], const pg8::Unit& u, int wr, int wc, int fr, int fq) const {
        const int row0 = u.pm * 256 + wr * 64 + fr, col0 = u.pn * 256 + wc * 32 + 4 * fq;
        f32x4 xq[3][4];
#pragma unroll
        for (int pre = 0; pre < 3; ++pre) {
            const int rowp = row0 + (pre >> 2) * 128 + (pre & 3) * 16;
#pragma unroll
            for (int q = 0; q < 4; ++q) xq[pre][q] = __builtin_nontemporal_load((const f32x4*)(X + (size_t)rowp * DM + col0 + (q >> 1) * 128 + (q & 1) * 16));
        }
#pragma unroll
        for (int it = 0; it < 8; ++it) {
            const int ai = it >> 2, m = it & 3;
            const int row = row0 + ai * 128 + m * 16;
            f32x4 xc[4];
#pragma unroll
            for (int q = 0; q < 4; ++q) xc[q] = xq[it % 3][q];
            if (it + 3 < 8) {
                const int rown = row0 + ((it + 3) >> 2) * 128 + ((it + 3) & 3) * 16;
#pragma unroll
                for (int q = 0; q < 4; ++q) xq[it % 3][q] = __builtin_nontemporal_load((const f32x4*)(X + (size_t)rown * DM + col0 + (q >> 1) * 128 + (q & 1) * 16));
            }
            float s = 0.f;
#pragma unroll
            for (int bj = 0; bj < 2; ++bj)
#pragma unroll
                for (int n = 0; n < 2; ++n) {
                    const f32x4 v = acc[ai][bj][m][n] + xc[bj * 2 + n];
                    acc[ai][bj][m][n] = v;
                    if (!fused) *(f32x4*)(O + (size_t)row * DM + col0 + bj * 128 + n * 16) = v;
                    s += (v[0] * v[0] + v[1] * v[1]) + (v[2] * v[2] + v[3] * v[3]);
                }
            s += __shfl_xor(s, 16); s += __shfl_xor(s, 32);
            if (!fused) { if (fq == 0) atomicAdd(ssq + row, s); }
            else if (fq == 0) part[((wr * 8 + it) * 16 + fr) * 4 + wc] = s;
        }
        if (!fused) return;
        asm volatile("s_waitcnt lgkmcnt(0)" ::: "memory"); __builtin_amdgcn_s_barrier(); asm volatile("" ::: "memory");
        {
            const int l5 = fr + 16 * (fq & 1), itq = 2 * wc + (l5 >> 4);
            if (fq < 2) {
                const f32x4 pp = *(const LAS f32x4*)(part + ((wr * 8 + itq) * 16 + fr) * 4);
                atomicAdd(ssq + u.pm * 256 + wr * 64 + fr + (itq >> 2) * 128 + (itq & 3) * 16, (pp[0] + pp[1]) + (pp[2] + pp[3]));
            }
        }
        asm volatile("s_waitcnt vmcnt(0)" ::: "memory");
        unsigned* c = cnt + 64 * u.pm;
        if (fr == 0 && fq == 0) (void)__hip_atomic_fetch_add(c, 1u, __ATOMIC_RELAXED, __HIP_MEMORY_SCOPE_AGENT);
        asm volatile("" ::: "memory"); __builtin_amdgcn_s_barrier(); asm volatile("" ::: "memory");
        if (wr == 0 && wc == 0) {
            unsigned sp = 0;
            while (__hip_atomic_load(c, __ATOMIC_RELAXED, __HIP_MEMORY_SCOPE_AGENT) < 32u) { __builtin_amdgcn_s_sleep(1); if (++sp > (1u << 20)) break; }
        }
        asm volatile("" ::: "memory"); __builtin_amdgcn_s_barrier(); asm volatile("" ::: "memory");
        f32x4 g4[2][2];
#pragma unroll
        for (int bj = 0; bj < 2; ++bj)
#pragma unroll
            for (int n = 0; n < 2; ++n) g4[bj][n] = *(const f32x4*)(fg + col0 + bj * 128 + n * 16);
        float sv[2][4];
#pragma unroll
        for (int ai = 0; ai < 2; ++ai)
#pragma unroll
            for (int m = 0; m < 4; ++m) sv[ai][m] = __hip_atomic_load(ssq + row0 + ai * 128 + m * 16, __ATOMIC_RELAXED, __HIP_MEMORY_SCOPE_AGENT);
#pragma unroll
        for (int ai = 0; ai < 2; ++ai)
#pragma unroll
            for (int m = 0; m < 4; ++m) {
                const int row = row0 + ai * 128 + m * 16;
                const float rs = rsqrtf(sv[ai][m] * (1.0f / DM) + EPS);
#pragma unroll
                for (int bj = 0; bj < 2; ++bj)
#pragma unroll
                    for (int n = 0; n < 2; ++n)
                        *(f32x4*)(O + (size_t)row * DM + col0 + bj * 128 + n * 16) = acc[ai][bj][m][n] * rs * g4[bj][n];
                asm volatile("" ::: "memory");
            }
    }
};

template <int MODE>
DI void transpose_wtile(const Params& p, int n0, int k0) {
    const int lane = threadIdx.x & 63, k = k0 + lane;
    float g;
    if (MODE == 1) g = p.norm_g[k];
    if (MODE == 2) g = p.q_norm_g[k];
    if (MODE == 3) g = (k < 512 ? p.attn_out_g[k] : p.conv_out_g[k - 512]);
    if (MODE == 4) g = p.kv_norm_g[k];
    float v[16];
    const bool vec4 = (MODE == 3) || (MODE == 4) || (MODE == 1 && !(n0 >= C_KR && n0 < C_ZA) && !(n0 >= C_PAD && n0 < C_CONV));
    if (vec4) {
#pragma unroll
        for (int q = 0; q < 4; ++q) {
            const int n = n0 + 4 * q;
            f32x4 w;
            if (MODE == 1) w = *(const f32x4*)(p.w_in + (size_t)k * NIN + colmap1(n));
            if (MODE == 2) w = (f32x4){0.f, 0.f, 0.f, 0.f};
            if (MODE == 3) w = *(const f32x4*)(p.w_out + (size_t)k * DM + n);
            if (MODE == 4) w = *(const f32x4*)(p.w_kv_up + (size_t)k * 1024 + (n >> 7) * 256 + 128 + (n & 127));
#pragma unroll
            for (int j = 0; j < 4; ++j) v[4 * q + j] = w[j] * g;
        }
    } else {
#pragma unroll
        for (int i = 0; i < 16; ++i) {
            const int n = n0 + i;
            float w = 0.f;
            if (MODE == 1) { const int c = colmap1(n); if (c >= 0) w = p.w_in[(size_t)k * NIN + c]; }
            if (MODE == 2) w = p.w_q_up[(size_t)k * 768 + colmap2q(n)];
            v[i] = w * g;
        }
    }
    bf16_t* dst = (bf16_t*)(p.ws + (MODE == 1 ? WS_W1T : (MODE == 2 ? WS_W2T : (MODE == 3 ? WS_W3T : WS_WVT))));
    const int ldd = (MODE == 2) ? K2 : (MODE == 4 ? 128 : DM);
    const int kd = (MODE == 4) ? ((k & ~15) | ((k & 4) << 1) | ((k & 8) >> 1) | (k & 3)) : k;
#pragma unroll
    for (int i = 0; i < 16; ++i) dst[(size_t)(n0 + i) * ldd + kd] = f2bf(v[i]);
}
DI void wqk_task(const Params& p, int u) {
    const int lane = threadIdx.x & 63, k = (u & 3) * 64 + lane, hc = u >> 2, h = hc >> 5, c0 = (hc & 31) * 4;
    float a[4] = {0.f, 0.f, 0.f, 0.f};
    const float* qrow = p.w_q_up + (size_t)k * 768 + h * 192;
    const float* kb = p.w_kv_up + (size_t)c0 * 1024 + h * 256;
#pragma unroll 1
    for (int ec = 0; ec < 4; ++ec) {
        f32x4 q[8];
#pragma unroll
        for (int i = 0; i < 8; ++i) q[i] = *(const f32x4*)(qrow + ec * 32 + 4 * i);
#pragma unroll
        for (int ci = 0; ci < 4; ++ci)
#pragma unroll
            for (int i = 0; i < 8; ++i) {
                const f32x4 w = *(const f32x4*)(kb + (size_t)ci * 1024 + ec * 32 + 4 * i);
                a[ci] += (q[i][0] * w[0] + q[i][1] * w[1]) + (q[i][2] * w[2] + q[i][3] * w[3]);
            }
    }
    const float gq = p.q_norm_g[k];
    bf16_t* dst = (bf16_t*)(p.ws + WS_W2T);
#pragma unroll
    for (int ci = 0; ci < 4; ++ci) dst[(size_t)(h * 192 + c0 + ci) * K2 + k] = f2bf(a[ci] * gq * p.kv_norm_g[c0 + ci]);
}

DI void phase0(const Params& p) {
    const int tid = threadIdx.x, wid = __builtin_amdgcn_readfirstlane(tid >> 6), lane = tid & 63, nb = gridDim.x, bid = blockIdx.x;
    const int gw = bid * 2 + wid, nw = nb * 2;
    if (wid < 2) {
    {
        float* cs = (float*)(p.ws + WS_CS);
        for (int i = gw * 64 + lane; i < 2064 * 32; i += nw * 64) {
            const int pos = i >> 5, f = i & 31;
            const float ang = (float)pos * p.inv_freq[f];
            double rev = (double)ang * 0.15915494309189535; rev -= rint(rev);
            const float r = (float)rev;
            cs[2 * i] = __builtin_amdgcn_cosf(r); cs[2 * i + 1] = __builtin_amdgcn_sinf(r);
        }
        float* z = (float*)(p.ws + WS_SSQQ);
        for (int i = gw * 64 + lane; i < 3 * NTOK; i += nw * 64) z[i] = 0.f;
    }
    for (int u = gw; u < 512; u += nw) wqk_task(p, u);
    for (int r = gw; r < NMETA; r += nw) {
        bf16_t* MG = (bf16_t*)(p.ws + WS_MG); float ss = 0.f;
#pragma unroll
        for (int i = 0; i < 4; ++i) {
            const int k = lane * 4 + 256 * i;
            const f32x4 m = *(const f32x4*)(p.meta + r * DM + k), g = *(const f32x4*)(p.norm_g + k);
            ss += (m[0] * m[0] + m[1] * m[1]) + (m[2] * m[2] + m[3] * m[3]);
            u32x2 w; w.x = cvt_pk_bf16(m[0] * g[0], m[1] * g[1]); w.y = cvt_pk_bf16(m[2] * g[2], m[3] * g[3]);
            *(u32x2*)(MG + r * DM + k) = w;
        }
        ss = wave_sum(ss);
        if (lane == 0) ((float*)(p.ws + WS_RSTDM))[r] = rsqrtf(ss * (1.0f / DM) + EPS);
    }
    {
        constexpr int T1 = (N1 / 16) * (DM / 64), T2 = 16 * (K2 / 64), T3 = (DM / 16) * (DM / 64), T4 = 32 * 2;
        for (int t = gw; t < T1 + T2 + T3 + T4; t += nw) {
            if (t < T1) transpose_wtile<1>(p, (t >> 4) * 16, (t & 15) * 64);
            else if (t < T1 + T2) { const int u = t - T1, nt = u >> 2; transpose_wtile<2>(p, (nt >> 2) * 192 + 128 + (nt & 3) * 16, (u & 3) * 64); }
            else if (t < T1 + T2 + T3) { const int u = t - T1 - T2; transpose_wtile<3>(p, (u >> 4) * 16, (u & 15) * 64); }
            else { const int u = t - T1 - T2 - T3; transpose_wtile<4>(p, (u >> 1) * 16, (u & 1) * 64); }
        }
    }
    }
    {
        bf16_t* XB = (bf16_t*)(p.ws + WS_XB); float* rstd = (float*)(p.ws + WS_RSTDH);
        for (int kk = (wid >= 2 ? wid - 2 : 30 + wid); ; kk += (wid >= 2 ? 6 : 32)) {
            if (wid >= 2 && (kk % 32) >= 30) kk += 2;
            const int row = (bid + nb * kk) * 4;
            if (row >= NTOK) break;
            const float* xr = p.x + (size_t)row * DM;
            f32x4 v[16]; float s[4] = {0.f, 0.f, 0.f, 0.f};
#pragma unroll
            for (int i = 0; i < 16; ++i) v[i] = __builtin_nontemporal_load((const f32x4*)(xr + (i >> 2) * DM + lane * 4 + 256 * (i & 3)));
#pragma unroll
            for (int i = 0; i < 16; ++i) s[i >> 2] += (v[i][0] * v[i][0] + v[i][1] * v[i][1]) + (v[i][2] * v[i][2] + v[i][3] * v[i][3]);
#pragma unroll
            for (int i = 0; i < 16; ++i) { u32x2 w; w.x = cvt_pk_bf16(v[i][0], v[i][1]); w.y = cvt_pk_bf16(v[i][2], v[i][3]); *(u32x2*)(XB + (size_t)(row + (i >> 2)) * DM + lane * 4 + 256 * (i & 3)) = w; }
#pragma unroll
            for (int r = 0; r < 4; ++r) { const float t = wave_sum(s[r]); if (lane == 0) rstd[row + r] = rsqrtf(t * (1.0f / DM) + EPS); }
        }
    }
}

DI void meta_tile(const Params& p, int n0) {
    const int lane = threadIdx.x & 63, c = lane & 15, q = lane >> 4;
    const bf16_t* MG = (const bf16_t*)(p.ws + WS_MG) + c * DM + 8 * q;
    const bf16_t* W = (const bf16_t*)(p.ws + WS_W1T) + (size_t)(n0 + c) * DM + 8 * q;
    f32x4 acc = (f32x4){0.f, 0.f, 0.f, 0.f};
#pragma unroll 8
    for (int s = 0; s < 32; ++s) {
        const bf16x8 a = *(const bf16x8*)(MG + 32 * s), b = *(const bf16x8*)(W + 32 * s);
        acc = __builtin_amdgcn_mfma_f32_16x16x32_bf16(a, b, acc, 0, 0, 0);
    }
    const float* rsm = (const float*)(p.ws + WS_RSTDM);
    bf16_t* PM = (bf16_t*)(p.ws + WS_PMETA);
#pragma unroll
    for (int r = 0; r < 4; ++r) PM[(4 * q + r) * N1 + n0 + c] = f2bf(acc[r] * rsm[4 * q + r]);
}
DI void meta_inproj(const Params& p) {
    const int wid = __builtin_amdgcn_readfirstlane(threadIdx.x >> 6), nb = gridDim.x, bid = blockIdx.x;
    for (int ti = bid; ti < 192; ti += nb) if (((ti / nb) & 7) == wid) meta_tile(p, ti * 16);
}

constexpr int KROW = 400, VROW = 320;
constexpr int KBUF = 64 * KROW, VBUF = 64 * VROW;
constexpr int WVT_LDS = 2 * KBUF + 2 * VBUF, WVROW = 272;
DI s16x4 tr16(const LAS unsigned char* a) { return __builtin_amdgcn_ds_read_tr16_b64_v4i16((LAS s16x4*)a); }

struct TileRegs { u32x4 k[3]; float ssq; };
DI void attn_load_meta(const Params& p, TileRegs& R) {
    const int t = threadIdx.x, row = t >> 3, cg = t & 7;
    const u32x4 zero = (u32x4){0u, 0u, 0u, 0u};
    R.k[0] = zero; R.k[1] = zero; R.k[2] = zero; R.ssq = 0.f;
    if (row < NMETA) {
        const bf16_t* PM = (const bf16_t*)(p.ws + WS_PMETA) + row * N1;
        const u32x4 a = *(const u32x4*)(PM + C_CKV + cg * 8), b = *(const u32x4*)(PM + C_CKV + 64 + cg * 8), c = *(const u32x4*)(PM + C_KR + cg * 8);
        float ss = bf_lo(a.x) * bf_lo(a.x) + bf_hi(a.x) * bf_hi(a.x) + bf_lo(a.y) * bf_lo(a.y) + bf_hi(a.y) * bf_hi(a.y)
                 + bf_lo(a.z) * bf_lo(a.z) + bf_hi(a.z) * bf_hi(a.z) + bf_lo(a.w) * bf_lo(a.w) + bf_hi(a.w) * bf_hi(a.w)
                 + bf_lo(b.x) * bf_lo(b.x) + bf_hi(b.x) * bf_hi(b.x) + bf_lo(b.y) * bf_lo(b.y) + bf_hi(b.y) * bf_hi(b.y)
                 + bf_lo(b.z) * bf_lo(b.z) + bf_hi(b.z) * bf_hi(b.z) + bf_lo(b.w) * bf_lo(b.w) + bf_hi(b.w) * bf_hi(b.w);
        ss += __shfl_xor(ss, 1); ss += __shfl_xor(ss, 2); ss += __shfl_xor(ss, 4);
        R.k[0] = a; R.k[1] = b; R.ssq = ss;
        f32x4 t0, t1, v0, v1;
        rope8_load(t0, t1, (const float*)(p.ws + WS_CS), row, cg * 4);
        v0[0] = bf_lo(c.x); v0[1] = bf_hi(c.x); v0[2] = bf_lo(c.y); v0[3] = bf_hi(c.y); v1[0] = bf_lo(c.z); v1[1] = bf_hi(c.z); v1[2] = bf_lo(c.w); v1[3] = bf_hi(c.w);
        rope8_apply(v0, v1, t0, t1);
        R.k[2] = pack8(v0, v1);
    }
}
DI void attn_load_tile(TileRegs& R, const bf16_t* kvp, const bf16_t* kpp, const float* sqp) {
    R.k[0] = *(const u32x4*)(kvp); R.k[1] = *(const u32x4*)(kvp + 64); R.k[2] = *(const u32x4*)(kpp); R.ssq = *sqp;
}
DI u32x4 scale8(const u32x4& u, float rs) {
    u32x4 w;
    w.x = cvt_pk_bf16(bf_lo(u.x) * rs, bf_hi(u.x) * rs); w.y = cvt_pk_bf16(bf_lo(u.y) * rs, bf_hi(u.y) * rs);
    w.z = cvt_pk_bf16(bf_lo(u.z) * rs, bf_hi(u.z) * rs); w.w = cvt_pk_bf16(bf_lo(u.w) * rs, bf_hi(u.w) * rs);
    return w;
}
DI void attn_store_tile(const TileRegs& R, LAS unsigned char* kb, LAS unsigned char* vb) {
    const int t = threadIdx.x, row = t >> 3, cg = t & 7;
    LAS unsigned char* kd = kb + row * KROW + cg * 16; LAS unsigned char* vd = vb + row * VROW + cg * 16;
    const float rs = rsqrtf(R.ssq * (1.0f / 128.0f) + EPS);
    const u32x4 n0 = scale8(R.k[0], rs), n1 = scale8(R.k[1], rs);
    *(LAS u32x4*)(kd) = n0; *(LAS u32x4*)(kd + 128) = n1; *(LAS u32x4*)(kd + 256) = R.k[2];
    *(LAS u32x4*)(vd) = n0; *(LAS u32x4*)(vd + 128) = n1;
}

constexpr int WQROW = 272, WQHALF = 192 * WQROW;
DI void q_stage(const Params& p, LAS unsigned char* lds, int h) {
    const bf16_t* W = (const bf16_t*)(p.ws + WS_W2T) + (size_t)h * 192 * K2;
#pragma unroll
    for (int i = 0; i < 12; ++i) {
        const int id = threadIdx.x + 512 * i, row = id >> 5, cc = id & 31;
        *(LAS u32x4*)(lds + (cc >> 4) * WQHALF + row * WQROW + (cc & 15) * 16) = *(const u32x4*)(W + row * K2 + cc * 8);
    }
}
DI void q_block(const Params& p, const LAS unsigned char* lds, int b, int h, int j) {
    const int tid = threadIdx.x, wid = tid >> 6, lane = tid & 63, r = lane & 31, hh = lane >> 5;
    const int qs = 256 * j + 32 * wid + r;
    const size_t qrow = (size_t)b * SEQ + qs;
    const bf16_t* cqp = (const bf16_t*)(p.ws + WS_P) + qrow * N1 + 8 * hh;
    bf16x8 cq[16];
#pragma unroll
    for (int s = 0; s < 16; ++s) cq[s] = *(const bf16x8*)(cqp + 16 * s);
    const float rsq = rsqrtf(((const float*)(p.ws + WS_SSQQ))[qrow] * (1.0f / 256.0f) + EPS) * QSCALE;
    const float* cs = (const float*)(p.ws + WS_CS) + ((size_t)(qs + NMETA) * 32 + 2 * hh) * 2;
    bf16_t* Qu = (bf16_t*)(p.ws + WS_Q) + ((size_t)((((b * 4 + h) * 8 + j) * 8 + __builtin_amdgcn_readfirstlane(wid)) * 12)) * 512;
    const unsigned qlo = lane * 8;
    const LAS unsigned char* wl = lds + r * WQROW + 16 * hh;
    f32x16 acc[6];
#pragma unroll
    for (int dt = 0; dt < 6; ++dt)
#pragma unroll
        for (int i = 0; i < 16; ++i) acc[dt][i] = 0.f;
#pragma unroll
    for (int s = 0; s < 16; ++s) {
#pragma unroll
        for (int d3 = 0; d3 < 6; d3 += 3) {
            bf16x8 af[3];
#pragma unroll
            for (int dt = 0; dt < 3; ++dt) af[dt] = *(const LAS bf16x8*)(wl + (s >> 3) * WQHALF + (d3 + dt) * 32 * WQROW + (s & 7) * 32);
#pragma unroll
            for (int dt = 0; dt < 3; ++dt) acc[d3 + dt] = __builtin_amdgcn_mfma_f32_32x32x16_bf16(af[dt], cq[s], acc[d3 + dt], 0, 0, 0);
        }
    }
    asm volatile("" : "+v"(cs));
    f32x4 tr[8];
#pragma unroll
    for (int i = 0; i < 8; ++i) tr[i] = *(const f32x4*)(cs + (16 * (i >> 2) + 4 * (i & 3)) * 2);
#pragma unroll
    for (int dt = 0; dt < 6; ++dt)
#pragma unroll
        for (int gp = 0; gp < 2; ++gp) {
            u32x2 wq[2];
#pragma unroll
            for (int e = 0; e < 2; ++e) {
                const int g = 2 * gp + e;
                float v0 = acc[dt][4 * g] * rsq, v1 = acc[dt][4 * g + 1] * rsq, v2 = acc[dt][4 * g + 2] * rsq, v3 = acc[dt][4 * g + 3] * rsq;
                if (dt >= 4) {
                    const f32x4 t = tr[(dt - 4) * 4 + g];
                    const float a0 = v0 * t[0] - v1 * t[1], a1 = v1 * t[0] + v0 * t[1], a2 = v2 * t[2] - v3 * t[3], a3 = v3 * t[2] + v2 * t[3];
                    v0 = a0; v1 = a1; v2 = a2; v3 = a3;
                }
                wq[e].x = cvt_pk_bf16(v0, v1); wq[e].y = cvt_pk_bf16(v2, v3);
            }
            swap_x32(wq[0], wq[1]);
            u32x4 w; w.x = wq[0].x; w.y = wq[0].y; w.z = wq[1].x; w.w = wq[1].y;
            *(u32x4*)(Qu + (qlo + (2 * dt + gp) * 512)) = w;
        }
}

DI void attn_block(const Params& p, LAS unsigned char* lds, int b, int h, int j) {
    const int tid = threadIdx.x, wid = tid >> 6, lane = tid & 63, r = lane & 31, hh = lane >> 5;
    const bf16_t* QB = (const bf16_t*)(p.ws + WS_Q);
    const int qs = 256 * j + 32 * wid + r;
    const size_t qrow = (size_t)b * SEQ + qs;
    bf16x8 qf[12];
#pragma unroll
    for (int s = 0; s < 12; ++s) qf[s] = *(const bf16x8*)(QB + ((size_t)((((b * 4 + h) * 8 + j) * 8 + __builtin_amdgcn_readfirstlane(wid)) * 12)) * 512 + (unsigned)(lane * 8 + s * 512));
    f32x16 o[4];
#pragma unroll
    for (int d = 0; d < 4; ++d)
#pragma unroll
        for (int i = 0; i < 16; ++i) o[d][i] = 0.f;
    float mrun = -1e30f, lrun = 0.f;
    const int ntile = 4 * j + 5;
    const int wave_rowmax = 256 * j + 32 * wid + 31, wave_rowmin = 256 * j + 32 * wid;
    TileRegs R;
    attn_load_meta(p, R);
    attn_store_tile(R, lds, lds + 2 * KBUF);
    __syncthreads();
    const bf16_t* kvp = (const bf16_t*)(p.ws + WS_P) + ((size_t)b * SEQ + (tid >> 3)) * N1 + C_CKV + (tid & 7) * 8;
    const float* sqp = (const float*)(p.ws + WS_SSQKV) + (size_t)b * SEQ + (tid >> 3);
    const bf16_t* kpp = (const bf16_t*)(p.ws + WS_KPE) + ((size_t)b * SEQ + (tid >> 3)) * 64 + (tid & 7) * 8;
    const int koff = r * KROW + 16 * hh;
    const int voff = (4 * hh + ((lane & 15) >> 2)) * VROW + (16 * ((lane >> 4) & 1) + 4 * (lane & 3)) * 2;
    for (int kt = 0; kt < ntile; ++kt) {
        const int cur = kt & 1;
        if (kt + 1 < ntile) { attn_load_tile(R, kvp, kpp, sqp); kvp += 64 * N1; kpp += 64 * 64; sqp += 64; }
        const LAS unsigned char* kb = lds + cur * KBUF;
        const LAS unsigned char* vb = lds + 2 * KBUF + cur * VBUF;
        const int kbase = (kt - 1) * 64;
        const bool active = (kt == 0) || (kbase <= wave_rowmax);
        if (active) {
            const bool need_mask = (kt == 0) || (kbase + 63 > wave_rowmin);
#pragma unroll
            for (int sub = 0; sub < 2; ++sub) {
                f32x16 s;
#pragma unroll
                for (int i = 0; i < 16; ++i) s[i] = 0.f;
#pragma unroll
                for (int st = 0; st < 12; ++st) {
                    const bf16x8 kf = *(const LAS bf16x8*)(kb + koff + sub * 32 * KROW + st * 32);
                    s = __builtin_amdgcn_mfma_f32_32x32x16_bf16(kf, qf[st], s, 0, 0, 0);
                }
                __builtin_amdgcn_sched_group_barrier(0x100, 4, 0);
#pragma unroll
                for (int i = 0; i < 8; ++i) { __builtin_amdgcn_sched_group_barrier(0x008, 1, 0); __builtin_amdgcn_sched_group_barrier(0x100, 1, 0); }
                __builtin_amdgcn_sched_group_barrier(0x008, 4, 0);
                if (need_mask) {
#pragma unroll
                    for (int i = 0; i < 16; ++i) {
                        const int krow = 32 * sub + (i & 3) + 8 * (i >> 2) + 4 * hh;
                        const bool valid = (kt == 0) ? (krow < NMETA) : (kbase + krow <= qs);
                        s[i] = valid ? s[i] : -1e30f;
                    }
                }
                float mt = s[0];
#pragma unroll
                for (int i = 1; i < 16; ++i) mt = fmaxf(mt, s[i]);
                mt = max_x32(mt);
                if (__builtin_amdgcn_ballot_w64(mt - mrun > 8.0f) != 0ull) {
                    const float mnew = fmaxf(mrun, mt);
                    const float alpha = __builtin_amdgcn_exp2f(mrun - mnew);
                    mrun = mnew;
                    lrun *= alpha;
#pragma unroll
                    for (int d = 0; d < 4; ++d)
#pragma unroll
                        for (int i = 0; i < 16; ++i) o[d][i] *= alpha;
                }
                float ps = 0.f;
#pragma unroll
                for (int i = 0; i < 16; ++i) { s[i] = __builtin_amdgcn_exp2f(s[i] - mrun); ps += s[i]; }
                lrun += ps;
                bf16x8 pb[2];
#pragma unroll
                for (int s2 = 0; s2 < 2; ++s2) {
                    u32x4 w;
                    w.x = cvt_pk_bf16(s[8 * s2 + 0], s[8 * s2 + 1]); w.y = cvt_pk_bf16(s[8 * s2 + 2], s[8 * s2 + 3]);
                    w.z = cvt_pk_bf16(s[8 * s2 + 4], s[8 * s2 + 5]); w.w = cvt_pk_bf16(s[8 * s2 + 6], s[8 * s2 + 7]);
                    pb[s2] = __builtin_bit_cast(bf16x8, w);
                }
#pragma unroll
                for (int d = 0; d < 4; ++d)
#pragma unroll
                    for (int s2 = 0; s2 < 2; ++s2) {
                        const LAS unsigned char* a = vb + voff + (32 * sub + 16 * s2) * VROW + d * 64;
                        const s16x4 lo = tr16(a), hi = tr16(a + 8 * VROW);
                        const bf16x8 vf = __builtin_shufflevector(lo, hi, 0, 1, 2, 3, 4, 5, 6, 7);
                        o[d] = __builtin_amdgcn_mfma_f32_32x32x16_bf16(vf, pb[s2], o[d], 0, 0, 0);
                    }
                __builtin_amdgcn_sched_group_barrier(0x100, 4, 0);
#pragma unroll
                for (int i = 0; i < 6; ++i) { __builtin_amdgcn_sched_group_barrier(0x008, 1, 0); __builtin_amdgcn_sched_group_barrier(0x100, 2, 0); }
                __builtin_amdgcn_sched_group_barrier(0x008, 2, 0);
                __builtin_amdgcn_sched_barrier(0);
            }
        }
        if (kt + 1 < ntile) attn_store_tile(R, lds + (cur ^ 1) * KBUF, lds + 2 * KBUF + (cur ^ 1) * VBUF);
        __syncthreads();
    }
    const float ltot = sum_x32(lrun);
    const float inv = 1.0f / ltot;
    f32x16 o2[4];
#pragma unroll
    for (int d = 0; d < 4; ++d)
#pragma unroll
        for (int i = 0; i < 16; ++i) o2[d][i] = 0.f;
    const LAS unsigned char* WVL = lds + WVT_LDS + r * WVROW + 16 * hh;
    const bf16_t* P = (const bf16_t*)(p.ws + WS_P) + qrow * N1 + C_ZA + h * 128 + 8 * hh;
    asm volatile("" : "+v"(P));
    u32x4 zq[8];
#pragma unroll
    for (int i = 0; i < 8; ++i) zq[i] = *(const u32x4*)(P + 32 * (i >> 1) + 16 * (i & 1));
#pragma unroll
    for (int d = 0; d < 4; ++d)
#pragma unroll
        for (int s2 = 0; s2 < 2; ++s2) {
            u32x4 w;
            w.x = cvt_pk_bf16(o[d][8 * s2 + 0] * inv, o[d][8 * s2 + 1] * inv); w.y = cvt_pk_bf16(o[d][8 * s2 + 2] * inv, o[d][8 * s2 + 3] * inv);
            w.z = cvt_pk_bf16(o[d][8 * s2 + 4] * inv, o[d][8 * s2 + 5] * inv); w.w = cvt_pk_bf16(o[d][8 * s2 + 6] * inv, o[d][8 * s2 + 7] * inv);
            const bf16x8 pb = __builtin_bit_cast(bf16x8, w);
            const int c0 = 32 * d + 16 * s2;
#pragma unroll
            for (int dvt = 0; dvt < 4; ++dvt) {
                const bf16x8 af = *(const LAS bf16x8*)(WVL + dvt * 32 * WVROW + c0 * 2);
                o2[dvt] = __builtin_amdgcn_mfma_f32_32x32x16_bf16(af, pb, o2[dvt], 0, 0, 0);
            }
            asm volatile("" ::: "memory");
        }
    float ss = 0.f;
#pragma unroll
    for (int d = 0; d < 4; ++d)
#pragma unroll
        for (int i = 0; i < 16; ++i) ss += o2[d][i] * o2[d][i];
    ss = sum_x32(ss);
    const float rs = rsqrtf(ss * (1.0f / 128.0f) + EPS);
    bf16_t* MIX = (bf16_t*)(p.ws + WS_MIX) + qrow * DM + h * 128 + 8 * hh;
    asm volatile("" : "+v"(MIX));
#pragma unroll
    for (int d = 0; d < 4; ++d)
#pragma unroll
        for (int gp = 0; gp < 2; ++gp) {
            u32x2 za, zb, wa, wb;
            za.x = zq[2 * d + gp].x; za.y = zq[2 * d + gp].y; zb.x = zq[2 * d + gp].z; zb.y = zq[2 * d + gp].w;
            swap_x32(za, zb);
            const int g = 2 * gp;
            wa.x = cvt_pk_bf16(o2[d][4 * g + 0] * rs * silu(bf_lo(za.x)), o2[d][4 * g + 1] * rs * silu(bf_hi(za.x)));
            wa.y = cvt_pk_bf16(o2[d][4 * g + 2] * rs * silu(bf_lo(za.y)), o2[d][4 * g + 3] * rs * silu(bf_hi(za.y)));
            wb.x = cvt_pk_bf16(o2[d][4 * g + 4] * rs * silu(bf_lo(zb.x)), o2[d][4 * g + 5] * rs * silu(bf_hi(zb.x)));
            wb.y = cvt_pk_bf16(o2[d][4 * g + 6] * rs * silu(bf_lo(zb.y)), o2[d][4 * g + 7] * rs * silu(bf_hi(zb.y)));
            swap_x32(wa, wb);
            u32x4 w; w.x = wa.x; w.y = wa.y; w.z = wb.x; w.w = wb.y;
            *(u32x4*)(MIX + 32 * d + 16 * gp) = w;
        }
}

DI void load8(const bf16_t* src, float (&f)[8]) {
    const u32x4 u = *(const u32x4*)src;
    f[0] = bf_lo(u.x); f[1] = bf_hi(u.x); f[2] = bf_lo(u.y); f[3] = bf_hi(u.y); f[4] = bf_lo(u.z); f[5] = bf_hi(u.z); f[6] = bf_lo(u.w); f[7] = bf_hi(u.w);
}
DI void load_bchz(const bf16_t* pr, float (&b)[8], float (&ch)[8], float (&z)[8]) {
    const u32x4 bc0 = *(const u32x4*)(pr), hz0 = *(const u32x4*)(pr + 128), bc1 = *(const u32x4*)(pr + 8), hz1 = *(const u32x4*)(pr + 136);
    b[0] = bf_lo(bc0.x); b[1] = bf_hi(bc0.x); b[2] = bf_lo(bc0.y); b[3] = bf_hi(bc0.y); b[4] = bf_lo(bc1.x); b[5] = bf_hi(bc1.x); b[6] = bf_lo(bc1.y); b[7] = bf_hi(bc1.y);
    ch[0] = bf_lo(bc0.z) * bf_lo(hz0.x); ch[1] = bf_hi(bc0.z) * bf_hi(hz0.x); ch[2] = bf_lo(bc0.w) * bf_lo(hz0.y); ch[3] = bf_hi(bc0.w) * bf_hi(hz0.y);
    ch[4] = bf_lo(bc1.z) * bf_lo(hz1.x); ch[5] = bf_hi(bc1.z) * bf_hi(hz1.x); ch[6] = bf_lo(bc1.w) * bf_lo(hz1.y); ch[7] = bf_hi(bc1.w) * bf_hi(hz1.y);
    z[0] = bf_lo(hz0.z); z[1] = bf_hi(hz0.z); z[2] = bf_lo(hz0.w); z[3] = bf_hi(hz0.w); z[4] = bf_lo(hz1.z); z[5] = bf_hi(hz1.z); z[6] = bf_lo(hz1.w); z[7] = bf_hi(hz1.w);
}
DI void conv_fix(const Params& p, int run  ) {
    const int lane = threadIdx.x & 63, c0 = lane * 8;
    const int colb = C_CONV + (lane >> 3) * 256 + ((lane & 7) >> 1) * 32 + (lane & 1) * 16;
    const bf16_t* P = (const bf16_t*)(p.ws + WS_P) + colb; const bf16_t* PM = (const bf16_t*)(p.ws + WS_PMETA) + colb;
    bf16_t* MIX = (bf16_t*)(p.ws + WS_MIX);
    float w0[8], w1[8], w2[8];
#pragma unroll
    for (int j = 0; j < 8; ++j) { w0[j] = p.conv_w[c0 + j]; w1[j] = p.conv_w[512 + c0 + j]; w2[j] = p.conv_w[1024 + c0 + j]; }
    const int R0 = run * 64;
    const bool first = (R0 & (SEQ - 1)) == 0;
    float bq[8], zq[8], ch2[8], ch1[8];
    load_bchz(first ? PM + 14 * N1 : P + (size_t)(R0 - 2) * N1, bq, ch2, zq);
    load_bchz(first ? PM + 15 * N1 : P + (size_t)(R0 - 1) * N1, bq, ch1, zq);
#pragma unroll
    for (int i = 0; i < 2; ++i) {
        float b[8], ch0[8], z[8], y[8];
        load_bchz(P + (size_t)(R0 + i) * N1, b, ch0, z);
        float ss = 0.f;
#pragma unroll
        for (int j = 0; j < 8; ++j) { y[j] = b[j] * (w0[j] * ch2[j] + w1[j] * ch1[j] + w2[j] * ch0[j]); ss += y[j] * y[j]; ch2[j] = ch1[j]; ch1[j] = ch0[j]; }
        ss += __shfl_xor(ss, 1); ss += __shfl_xor(ss, 2); ss += __shfl_xor(ss, 4);
        const float rs = rsqrtf(ss * (1.0f / 64.0f) + EPS);
#pragma unroll
        for (int j = 0; j < 8; ++j) y[j] = y[j] * rs * silu(z[j]);
        u32x4 w; w.x = cvt_pk_bf16(y[0], y[1]); w.y = cvt_pk_bf16(y[2], y[3]); w.z = cvt_pk_bf16(y[4], y[5]); w.w = cvt_pk_bf16(y[6], y[7]);
        *(u32x4*)(MIX + (size_t)(R0 + i) * DM + 512 + c0) = w;
    }
}

__global__ void __launch_bounds__(512) fwd_megakernel(Params p) {
    extern __shared__ __attribute__((aligned(16))) unsigned char shm[];
    LAS unsigned char* lds = (LAS unsigned char*)shm;
    cg::grid_group grid = cg::this_grid();
    const int nb = gridDim.x, bid = blockIdx.x;
#define PH_ON(n) (p.ph_lo <= (n) && (n) < p.ph_hi)
#define PH_SYNC(n) if (p.ph_lo < (n) && (n) < p.ph_hi) xcd_barrier(xb)
    volatile LAS unsigned* xst = (volatile LAS unsigned*)(lds + 131072);
    if (threadIdx.x < 4) xst[threadIdx.x] = 0u;
    __syncthreads();
    const XcdBarrier xb = xcd_barrier_post((unsigned*)(p.ws + WS_BAR), xst);
    if (p.ph_hi > 1000) grid.sync();
    {
        if (PH_ON(0)) {
            for (int rep = 0; rep < REP0; ++rep) phase0(p);
        }
        PH_SYNC(1);
        for (int rep = 0; rep < REPSYNC; ++rep) xcd_barrier(xb);
        if (PH_ON(1)) {
            pg8::Gemm g; g.A = (const bf16_t*)(p.ws + WS_XB); g.Bt = (const bf16_t*)(p.ws + WS_W1T); g.lda = DM; g.ldb = DM; g.K = DM; g.nM = NTOK / 256; g.nN = N1 / 256; g.aoff_pn = 1 << 30; g.aoff_bytes = 0;
            pg8::StaticOrder S; S.init(g.nM, g.nN, nb, bid);
            meta_inproj(p);
            Epi1 E; E.P = (bf16_t*)(p.ws + WS_P); E.KPE = (bf16_t*)(p.ws + WS_KPE); E.rstd = (const float*)(p.ws + WS_RSTDH); E.ssq_q = (float*)(p.ws + WS_SSQQ); E.ssq_kv = (float*)(p.ws + WS_SSQKV); E.cs = (const float*)(p.ws + WS_CS);
            E.MIX = (bf16_t*)(p.ws + WS_MIX); E.conv_w = p.conv_w; E.part = (LAS float*)(lds + 131072 + 64);
            E.acc_on = true; pg8::gemm_phase<Epi1>(lds, g, S, E);
#if REP1 > 1
            __syncthreads(); E.acc_on = false; pg8::gemm_phase<Epi1>(lds, g, S, E);
#endif
        }
        PH_SYNC(3);
        if (PH_ON(3)) for (int rep = 0; rep < REP3; ++rep) {
            for (int run = bid + nb * (threadIdx.x >> 6); run < NTOK / 64; run += nb * 8) conv_fix(p, run);
            if (bid < 256) {
                const int it = bid, xcd = it & 7, slot = it >> 3;
                const int b = 2 * xcd + (slot >> 4), h = (slot >> 2) & 3, jp = slot & 3;
                q_stage(p, lds, h);
                __syncthreads();
                q_block(p, lds, b, h, 7 - jp);
                q_block(p, lds, b, h, jp);
                __syncthreads();
                {
                    const bf16_t* WVT = (const bf16_t*)(p.ws + WS_WVT) + (size_t)h * 128 * 128;
#pragma unroll
                    for (int i = 0; i < 4; ++i) { const int id = threadIdx.x + 512 * i, row = id >> 4, cc = id & 15; *(LAS u32x4*)(lds + WVT_LDS + row * WVROW + cc * 16) = *(const u32x4*)(WVT + row * 128 + cc * 8); }
                }
                attn_block(p, lds, b, h, 7 - jp);
                attn_block(p, lds, b, h, jp);
            }

        }
        PH_SYNC(4);
        if (PH_ON(4)) {
            pg8::Gemm g; g.A = (const bf16_t*)(p.ws + WS_MIX); g.Bt = (const bf16_t*)(p.ws + WS_W3T); g.lda = DM; g.ldb = DM; g.K = DM; g.nM = NTOK / 256; g.nN = DM / 256; g.aoff_pn = 1 << 30; g.aoff_bytes = 0;
            pg8::StaticOrder S; S.init(g.nM, g.nN, nb, bid);
            Epi3 E; E.O = p.out; E.X = p.x; E.ssq = (float*)(p.ws + WS_SSQO); E.fg = p.final_g; E.cnt = (unsigned*)(p.ws + WS_BAR + 16384); E.fused = (nb == 256); E.part = (LAS float*)(lds + 131072 + 64);
            pg8::gemm_phase<Epi3>(lds, g, S, E);
        }
        if (nb != 256) { PH_SYNC(5); }
        if (PH_ON(5) && nb != 256) for (int rep = REP5 - 1; rep >= 0; --rep) {
            const float* ssq = (const float*)(p.ws + WS_SSQO);
            const int wid = threadIdx.x >> 6, lane = threadIdx.x & 63;
            f32x4 g4[4];
#pragma unroll
            for (int i = 0; i < 4; ++i) g4[i] = *(const f32x4*)(p.final_g + lane * 4 + 256 * i);
            for (int row = bid * 8 + wid; row < NTOK; row += nb * 8) {
                const float rs = rsqrtf(ssq[row] * (1.0f / DM) + EPS);
                float* orow = p.out + (size_t)row * DM;
                float* drow = rep ? (float*)(p.ws + WS_P) + (size_t)row * DM : orow;
#pragma unroll
                for (int i = 0; i < 4; ++i) { f32x4 v = *(const f32x4*)(orow + lane * 4 + 256 * i); v = v * rs * g4[i]; *(f32x4*)(drow + lane * 4 + 256 * i) = v; }
            }
        }
    }
}

extern "C" void kernel_launch(void* const* d_in, const int* in_sizes, int n_in, void* d_out, int out_size, void* d_ws, size_t ws_size, hipStream_t stream) {
    constexpr int LDS = 131072 + 64 + 4096;
    static int grid_blocks = 0;
    if (!grid_blocks) {
        int dev = 0, cus = 0, per_cu = 0;
        hipGetDevice(&dev);
        hipDeviceGetAttribute(&cus, hipDeviceAttributeMultiprocessorCount, dev);
        if (hipFuncSetAttribute((const void*)fwd_megakernel, hipFuncAttributeMaxDynamicSharedMemorySize, LDS) != hipSuccess) fprintf(stderr, "hipFuncSetAttribute failed\n");
        hipOccupancyMaxActiveBlocksPerMultiprocessor(&per_cu, (const void*)fwd_megakernel, 512, LDS);
        if (per_cu < 1) fprintf(stderr, "occupancy query says %d blocks per CU\n", per_cu);
        grid_blocks = cus;
        if (cus != 256) fprintf(stderr, "this kernel is laid out for a 256-CU device (got %d)\n", cus);
        if (ws_size < WS_END) fprintf(stderr, "workspace too small: %zu < %zu\n", ws_size, (size_t)WS_END);
    }
    Params p{};
    p.x = (const float*)d_in[0]; p.meta = (const float*)d_in[1]; p.norm_g = (const float*)d_in[2]; p.w_in = (const float*)d_in[3];
    p.q_norm_g = (const float*)d_in[4]; p.w_q_up = (const float*)d_in[5]; p.kv_norm_g = (const float*)d_in[6]; p.w_kv_up = (const float*)d_in[7];
    p.conv_w = (const float*)d_in[8]; p.attn_out_g = (const float*)d_in[9]; p.conv_out_g = (const float*)d_in[10]; p.w_out = (const float*)d_in[11];
    p.final_g = (const float*)d_in[12];
    p.out = (float*)d_out; p.ws = (unsigned char*)d_ws;
    for (int i = 0; i < 32; ++i) p.inv_freq[i] = 1.0f / powf(10000.0f, (float)i / 32.0f);
    p.ph_lo = 0; p.ph_hi = 6;
    if (hipMemsetAsync((char*)d_ws + WS_BAR, 0, 65536, stream) != hipSuccess) fprintf(stderr, "memset of the barrier words failed\n");
    void* args[] = {&p};
    hipError_t e = hipLaunchCooperativeKernel((void*)fwd_megakernel, dim3(grid_blocks), dim3(512), args, LDS, stream);
    if (e != hipSuccess) fprintf(stderr, "cooperative launch failed: %s (grid %d)\n", hipGetErrorString(e), grid_blocks);
}
```
